# Optimizing an MI355X kernel written in HIP

```python
import math
import jax, jax.numpy as jnp
from jax import lax
import numpy as np

D_MODEL = 1024
BATCH = 2
SEQ = 8192
DEPTH = 2
DEC_BATCH = 16
DEC_SEQ = 64
PAST_LEN = 4096

CHUNK = 64
Q_BLOCK = 128
N_EVEN = (DEPTH + 1) // 2
N_ODD = DEPTH // 2
EPS = 1e-6

SB_HEADS = 8
SB_DIM = 64
SB_WIDTH = SB_HEADS * SB_DIM
HG_HEADS = 4
HG_DK = 128
HG_DV = 128
HG_KW = HG_HEADS * HG_DK
HG_VW = HG_HEADS * HG_DV
EVEN_SPLITS = (SB_WIDTH, 2 * SB_WIDTH, 3 * SB_WIDTH, 3 * SB_WIDTH + HG_KW,
               3 * SB_WIDTH + 2 * HG_KW, 3 * SB_WIDTH + 2 * HG_KW + HG_VW)
EVEN_IN = 3 * SB_WIDTH + 2 * HG_KW + 2 * HG_VW
EVEN_OUT = SB_WIDTH + HG_VW
LRU_WIDTH = D_MODEL
LRU_BLOCKS = 8
LRU_BLK = LRU_WIDTH // LRU_BLOCKS
CONV_W = 4
C_SCALE = 8.0
D_FF = -(-8 * D_MODEL // (3 * 256)) * 256
N_MOD = 6

kernel_name = "hybrid_stickbreak_hgrn2_rglru_stream_step"

f32 = jnp.float32


def rms_norm(x, g):
    xf = x.astype(f32)
    return xf * lax.rsqrt(jnp.mean(xf * xf, -1, keepdims=True) + EPS) * g.astype(f32)


def sb_block(q, k, v, q_pos, k_pos):
    z = jnp.einsum('bqhd,bkhd->bhqk', q.astype(f32), k.astype(f32)) / math.sqrt(SB_DIM)
    mask = (k_pos[None, :] < q_pos[:, None])[None, None]
    log_1mb = jnp.where(mask, jax.nn.log_sigmoid(-z), 0.0)
    after = lax.cumsum(log_1mb, axis=3, reverse=True) - log_1mb
    w = jnp.where(mask, jnp.exp(jax.nn.log_sigmoid(z) + after), 0.0)
    return jnp.einsum('bhqk,bkhd->bqhd', w, v.astype(f32))


def sb_prompt(q, k, v):
    B, T, H, d = q.shape
    nb = T // Q_BLOCK
    qb = jnp.moveaxis(q.reshape(B, nb, Q_BLOCK, H, d), 1, 0)
    k_pos = jnp.arange(T)

    def one_block(args):
        qi, i = args
        return sb_block(qi, k, v, i * Q_BLOCK + jnp.arange(Q_BLOCK), k_pos)

    o = lax.map(one_block, (qb, jnp.arange(nb)))
    return jnp.moveaxis(o, 0, 1).reshape(B, T, H, d)


def hgrn_chunk(S, q, k, v, logf):
    L = q.shape[1]
    b = jnp.cumsum(logf, axis=1)
    causal = jnp.tril(jnp.ones((L, L), bool))[None, :, :, None, None]
    decay = jnp.exp(jnp.where(causal, b[:, :, None] - b[:, None, :], -jnp.inf))
    attn = jnp.einsum('bthc,bshc,btshc->bhts', q, k, decay)
    o = jnp.einsum('bhts,bshv->bthv', attn, v) + jnp.einsum('bthc,bhcv->bthv', q * jnp.exp(b), S)
    bL = b[:, -1]
    S_new = jnp.exp(bL)[..., None] * S + jnp.einsum('bshc,bshv->bhcv', k * jnp.exp(bL[:, None] - b), v)
    return S_new, o


def hgrn_prompt(q, k, v, logf):
    B, T, H, dk = q.shape
    n = T // CHUNK
    to_chunks = lambda t: jnp.moveaxis(t.reshape(B, n, CHUNK, H, t.shape[-1]), 1, 0)
    S0 = jnp.zeros((B, H, HG_DK, HG_DV), f32)
    S, o = lax.scan(lambda S, xs: hgrn_chunk(S, *xs), S0,
                    (to_chunks(q), to_chunks(k), to_chunks(v), to_chunks(logf)))
    return S, jnp.moveaxis(o, 0, 1).reshape(B, T, H, HG_DV)


def even_mix(hn, w_in, w_out, g_norm, lb, past_k, past_v, S0):
    B, T, _ = hn.shape
    p = (hn @ w_in).astype(f32)
    q_a, k_a, v_a, q_b, f_b, i_b, g_b = jnp.split(p, EVEN_SPLITS, axis=-1)
    q_a = q_a.reshape(B, T, SB_HEADS, SB_DIM)
    k_a = k_a.reshape(B, T, SB_HEADS, SB_DIM)
    v_a = v_a.reshape(B, T, SB_HEADS, SB_DIM)
    if past_k is None:
        o_a = sb_prompt(q_a, k_a, v_a)
    else:
        P = past_k.shape[1]
        keys = jnp.concatenate([past_k.astype(f32), k_a], axis=1)
        vals = jnp.concatenate([past_v.astype(f32), v_a], axis=1)
        o_a = sb_block(q_a, keys, vals, P + jnp.arange(T), jnp.arange(P + T))
    lbh = lb.reshape(HG_HEADS, HG_DK)
    f = lbh + (1.0 - lbh) * jax.nn.sigmoid(f_b.reshape(B, T, HG_HEADS, HG_DK))
    logf = jnp.log(f)
    k_b = 1.0 - f
    q_b = jax.nn.silu(q_b).reshape(B, T, HG_HEADS, HG_DK) * HG_DK ** -0.5
    i_b = i_b.reshape(B, T, HG_HEADS, HG_DV)
    if S0 is None:
        S, o_b = hgrn_prompt(q_b, k_b, i_b, logf)
    else:
        S, o_b = hgrn_chunk(S0.astype(f32), q_b, k_b, i_b, logf)
    o_b = o_b * lax.rsqrt(jnp.mean(o_b * o_b, -1, keepdims=True) + EPS) * g_norm.astype(f32).reshape(HG_HEADS, HG_DV)
    o_b = o_b.reshape(B, T, HG_VW) * jax.nn.silu(g_b)
    o = jnp.concatenate([o_a.reshape(B, T, SB_WIDTH), o_b], axis=-1).astype(hn.dtype) @ w_out
    return o, k_a.astype(hn.dtype), v_a.astype(hn.dtype), S


def _lin_comb(l, r):
    a_l, b_l = l
    a_r, b_r = r
    return a_l * a_r, a_r * b_l + b_r


def odd_mix(hn, w_in, conv_w, conv_b, wa, ba, wx, bx, lam, w_out, conv_past, h0):
    B, T, _ = hn.shape
    p = (hn @ w_in).astype(f32)
    gate_br, x_br = jnp.split(p, 2, axis=-1)
    pad = jnp.zeros((B, CONV_W - 1, LRU_WIDTH), f32) if conv_past is None else conv_past.astype(f32)
    xp = jnp.concatenate([pad, x_br], axis=1)
    cw = conv_w.astype(f32)
    xc = conv_b.astype(f32) + xp[:, 0:T] * cw[0]
    for j in range(1, CONV_W):
        xc = xc + xp[:, j:j + T] * cw[j]
    xb = xc.reshape(B, T, LRU_BLOCKS, LRU_BLK)
    r = jax.nn.sigmoid(jnp.einsum('bthi,hij->bthj', xb, wa.astype(f32)).reshape(B, T, LRU_WIDTH) + ba)
    gi = jax.nn.sigmoid(jnp.einsum('bthi,hij->bthj', xb, wx.astype(f32)).reshape(B, T, LRU_WIDTH) + bx)
    log_a = C_SCALE * r * jax.nn.log_sigmoid(lam.astype(f32))
    a = jnp.exp(log_a)
    mult = jnp.sqrt(-jnp.expm1(2.0 * log_a))
    if h0 is None:
        mult = jnp.where(jnp.arange(T)[None, :, None] == 0, 1.0, mult)
    u = mult * gi * xc
    if h0 is not None:
        u = u.at[:, 0].add(a[:, 0] * h0.astype(f32))
    _, h = lax.associative_scan(_lin_comb, (a, u), axis=1)
    y = (jax.nn.gelu(gate_br) * h).astype(hn.dtype) @ w_out
    return y, xp[:, -(CONV_W - 1):].astype(hn.dtype), h[:, -1]


def swiglu(h, wg, wu, wd):
    return (jax.nn.silu(h @ wg) * (h @ wu)) @ wd


def trunk(x, c, past_k, past_v, past_S, past_conv, past_h,
          norm_mix, norm_ffn, w_ada, b_ada, w_in_even, w_out_even, hg_gnorm, hg_lb_logits,
          w_in_odd, conv_w, conv_b, lru_wa, lru_ba, lru_wx, lru_bx, lru_lambda, w_out_odd,
          ffn_wg, ffn_wu, ffn_wd, final_norm):
    sample = past_k is not None
    B = x.shape[0]
    lb_all = jnp.cumsum(jax.nn.softmax(hg_lb_logits.astype(f32), axis=0), axis=0)
    sc = jax.nn.silu(c.astype(f32))
    new_k, new_v, new_S, new_conv, new_h = [], [], [], [], []
    for l in range(DEPTH):
        e = l // 2
        m = (sc @ w_ada[l].astype(f32) + b_ada[l]).reshape(B, N_MOD, D_MODEL)[:, :, None, :]
        sh1, sc1, g1, sh2, sc2, g2 = (m[:, i] for i in range(N_MOD))
        hn = (rms_norm(x, norm_mix[l]) * (1.0 + sc1) + sh1).astype(x.dtype)
        if l % 2 == 0:
            o, kn, vn, S = even_mix(hn, w_in_even[e], w_out_even[e], hg_gnorm[e], lb_all[l],
                                    past_k[e] if sample else None,
                                    past_v[e] if sample else None,
                                    past_S[e] if sample else None)
            new_k.append(kn)
            new_v.append(vn)
            new_S.append(S)
        else:
            o, cs, hl = odd_mix(hn, w_in_odd[e], conv_w[e], conv_b[e], lru_wa[e], lru_ba[e],
                                lru_wx[e], lru_bx[e], lru_lambda[e], w_out_odd[e],
                                past_conv[e] if sample else None,
                                past_h[e] if sample else None)
            new_conv.append(cs)
            new_h.append(hl)
        x = x + ((1.0 + g1) * o).astype(x.dtype)
        hn = (rms_norm(x, norm_ffn[l]) * (1.0 + sc2) + sh2).astype(x.dtype)
        x = x + ((1.0 + g2) * swiglu(hn, ffn_wg[l], ffn_wu[l], ffn_wd[l])).astype(x.dtype)
    y = rms_norm(x, final_norm).astype(x.dtype)
    return y, jnp.stack(new_k), jnp.stack(new_v), jnp.stack(new_S), jnp.stack(new_conv), jnp.stack(new_h)


def setup_inputs(seed: int = 0) -> dict:
    key = jax.random.key(seed)
    ks = iter(jax.random.split(key, 32))
    nrm = lambda shape, scale: jax.random.normal(next(ks), shape, f32) * scale
    a0 = jax.random.uniform(next(ks), (N_ODD, LRU_WIDTH), f32, minval=0.9, maxval=0.999)
    p = a0 ** (1.0 / C_SCALE)
    lru_lambda = jnp.log(p) - jnp.log1p(-p)
    return {
        "x_prompt": nrm((BATCH, SEQ, D_MODEL), 1.0),
        "x_sample": nrm((DEC_BATCH, DEC_SEQ, D_MODEL), 1.0),
        "cache_sb_k": nrm((N_EVEN, DEC_BATCH, PAST_LEN, SB_HEADS, SB_DIM), 1.0),
        "cache_sb_v": nrm((N_EVEN, DEC_BATCH, PAST_LEN, SB_HEADS, SB_DIM), 1.0),
        "state_hgrn": nrm((N_EVEN, DEC_BATCH, HG_HEADS, HG_DK, HG_DV), 0.3),
        "state_conv": nrm((N_ODD, DEC_BATCH, CONV_W - 1, LRU_WIDTH), 1.0),
        "state_lru": nrm((N_ODD, DEC_BATCH, LRU_WIDTH), 0.5),
        "c_prompt": nrm((BATCH, D_MODEL), 1.0),
        "c_sample": nrm((DEC_BATCH, D_MODEL), 1.0),
        "norm_mix": 1.0 + nrm((DEPTH, D_MODEL), 0.02),
        "norm_ffn": 1.0 + nrm((DEPTH, D_MODEL), 0.02),
        "w_ada": nrm((DEPTH, D_MODEL, N_MOD * D_MODEL), 0.2 * D_MODEL ** -0.5),
        "b_ada": nrm((DEPTH, N_MOD * D_MODEL), 0.02),
        "w_in_even": nrm((N_EVEN, D_MODEL, EVEN_IN), D_MODEL ** -0.5),
        "w_out_even": nrm((N_EVEN, EVEN_OUT, D_MODEL), EVEN_OUT ** -0.5),
        "hg_gnorm": 1.0 + nrm((N_EVEN, HG_VW), 0.02),
        "hg_lb_logits": nrm((DEPTH + 1, HG_KW), 0.5),
        "w_in_odd": nrm((N_ODD, D_MODEL, 2 * LRU_WIDTH), D_MODEL ** -0.5),
        "conv_w": nrm((N_ODD, CONV_W, LRU_WIDTH), CONV_W ** -0.5),
        "conv_b": nrm((N_ODD, LRU_WIDTH), 0.02),
        "lru_wa": nrm((N_ODD, LRU_BLOCKS, LRU_BLK, LRU_BLK), LRU_BLK ** -0.5),
        "lru_ba": nrm((N_ODD, LRU_WIDTH), 0.02),
        "lru_wx": nrm((N_ODD, LRU_BLOCKS, LRU_BLK, LRU_BLK), LRU_BLK ** -0.5),
        "lru_bx": nrm((N_ODD, LRU_WIDTH), 0.02),
        "lru_lambda": lru_lambda,
        "w_out_odd": nrm((N_ODD, LRU_WIDTH, D_MODEL), LRU_WIDTH ** -0.5),
        "ffn_wg": nrm((DEPTH, D_MODEL, D_FF), D_MODEL ** -0.5),
        "ffn_wu": nrm((DEPTH, D_MODEL, D_FF), D_MODEL ** -0.5),
        "ffn_wd": nrm((DEPTH, D_FF, D_MODEL), D_FF ** -0.5),
        "final_norm": 1.0 + nrm((D_MODEL,), 0.02),
    }


def reference(x_prompt, x_sample, cache_sb_k, cache_sb_v, state_hgrn, state_conv, state_lru,
              c_prompt, c_sample, norm_mix, norm_ffn, w_ada, b_ada, w_in_even, w_out_even,
              hg_gnorm, hg_lb_logits, w_in_odd, conv_w, conv_b, lru_wa, lru_ba, lru_wx, lru_bx,
              lru_lambda, w_out_odd, ffn_wg, ffn_wu, ffn_wd, final_norm):
    weights = (norm_mix, norm_ffn, w_ada, b_ada, w_in_even, w_out_even, hg_gnorm, hg_lb_logits,
               w_in_odd, conv_w, conv_b, lru_wa, lru_ba, lru_wx, lru_bx, lru_lambda, w_out_odd,
               ffn_wg, ffn_wu, ffn_wd, final_norm)
    y_prompt, k_p, v_p, S_p, conv_p, h_p = trunk(x_prompt, c_prompt, None, None, None, None, None, *weights)
    y_sample, k_s, v_s, S_s, conv_s, h_s = trunk(x_sample, c_sample, cache_sb_k, cache_sb_v, state_hgrn,
                                                 state_conv, state_lru, *weights)
    return (y_prompt, y_sample, k_p, v_p, S_p, conv_p, h_p, k_s, v_s, S_s, conv_s, h_s)
```

```cpp
#include <hip/hip_runtime.h>
#include <hip/hip_cooperative_groups.h>
#include <cstdio>
#include <cstdint>
namespace cg = cooperative_groups;
namespace pg8 {
#define PG8_LAS __attribute__((address_space(3)))
typedef unsigned short bf16_t;
typedef short bf16x8 __attribute__((ext_vector_type(8)));
typedef float f32x4 __attribute__((ext_vector_type(4)));
typedef unsigned u32x4 __attribute__((ext_vector_type(4)));
constexpr int BM = 256, BK = 64, HALF = 128, HTB = HALF * BK * 2  , STAGE_BYTES = 8 * HTB, NXCD = 8, WGM = 8;

__host__ __device__ __forceinline__ int lds_byte(int r, int c) { const int st = (r >> 4) * 2 + (c >> 5), rr = r & 15, cc = c & 31, ob = rr * 64 + cc * 2; return st * 1024 + (ob ^ (((ob >> 9) & 1) << 5)); }
__host__ __device__ __forceinline__ void stage_rc(int b, int& R, int& C) { const int st = b / 1024, sb = b % 1024, swz = sb ^ (((sb >> 9) & 1) << 5); R = (st >> 1) * 16 + swz / 64; C = (st & 1) * 32 + (swz % 64) / 2; }
__host__ __device__ __forceinline__ int perm32(int rho) { const int n = rho >> 4, i = rho & 15; return 8 * (i >> 2) + 4 * n + (i & 3); }

struct Unit { int pm, pn, kofs; };
struct Gemm { const bf16_t* A; const bf16_t* Bt; int M, N, K, ld; };

struct StaticOrder {
    int nM, nN, nwg, G, c;
    __host__ __device__ void init(int M, int N, int G_, int c_) { nM = M / BM; nN = N / BM; nwg = nM * nN; G = G_; c = c_; }
    __host__ __device__ bool next(int i, Unit& u) const {
        const long L = (long)i * G + c; if (L >= nwg) return false;
        int wgid = (int)L; { const int q = nwg / NXCD, r = nwg % NXCD, xcd = wgid % NXCD, off = wgid / NXCD; wgid = (xcd < r ? xcd * (q + 1) : r * (q + 1) + (xcd - r) * q) + off; }
        const int nig = WGM * nN, gid = wgid / nig, fm = gid * WGM, gsz = (nM - fm) < WGM ? (nM - fm) : WGM;
        u.pm = fm + ((wgid % nig) % gsz); u.pn = (wgid % nig) / gsz; u.kofs = 0; return true;
    }
    __device__ __forceinline__ void a_ready(const Unit&) const {}
    __device__ __forceinline__ void done(const Unit&) const {}
};

__device__ __forceinline__ unsigned cvt_pk_bf16(float lo, float hi) { unsigned r; asm volatile("v_cvt_pk_bf16_f32 %0, %1, %2" : "=v"(r) : "v"(lo), "v"(hi)); return r; }
typedef float f32x2 __attribute__((ext_vector_type(2)));
template <class Epi, class Sched, bool ALIGN_EPI = false, bool SP2 = false>
__device__ __forceinline__ void gemm_phase(PG8_LAS unsigned char* lds, const Gemm g, const Sched& S, const Epi& E) {
    const int tid = threadIdx.x, wid = __builtin_amdgcn_readfirstlane(tid >> 6), lane = tid & 63, wr = wid >> 2, wc = wid & 3, fr = lane & 15, fq = lane >> 4;
    const int K = g.ld, nt = g.K / BK;
    unsigned voffA[2], voffB[2];
#pragma unroll
    for (int i = 0; i < 2; ++i) { int R, C; stage_rc(tid * 16 + i * 8192, R, C); const int Rb = Epi::PERM ? ((R & ~31) + perm32(R & 31)) : R;
        voffA[i] = (unsigned)(R * K + C) * 2u; voffB[i] = (unsigned)(Rb * K + C) * 2u; }
    const size_t kstep = (size_t)(BK * 2);
    const size_t hstep = (size_t)HALF * K * 2;
    const size_t tstep = 2 * hstep;
    const unsigned ldsw = (unsigned)wid * 1024u;
    const int aoff = lds_byte(wr * 64 + fr, fq * 8), boff = lds_byte(wc * 32 + fr, fq * 8);
#define PG8_SA(b, h) (((b) * 2 + (h)) * HTB)
#define PG8_SB(b, h) ((4 + (b) * 2 + (h)) * HTB)
#define PG8_STAGE(bufoff, gbase, voff) do { _Pragma("unroll") for (int _i = 0; _i < 2; ++_i) \
        __builtin_amdgcn_global_load_lds((const unsigned*)((const char*)(gbase) + (voff)[_i]), (PG8_LAS unsigned*)(lds + (bufoff) + ldsw + _i * 8192), 16, 0, 0); } while (0)
#define PG8_LDA(dst, b, h) do { _Pragma("unroll") for (int m = 0; m < 4; ++m) _Pragma("unroll") for (int k = 0; k < 2; ++k) dst[m][k] = *(const PG8_LAS bf16x8*)(lds + PG8_SA(b, h) + aoff + m * 2048 + k * 1024); } while (0)
#define PG8_LDB(dst, b, h) do { _Pragma("unroll") for (int n = 0; n < 2; ++n) _Pragma("unroll") for (int k = 0; k < 2; ++k) dst[n][k] = *(const PG8_LAS bf16x8*)(lds + PG8_SB(b, h) + boff + n * 2048 + k * 1024); } while (0)
#define PG8_MMA(ai, bj, At, Bt) do { __builtin_amdgcn_s_setprio(1); _Pragma("unroll") for (int m = 0; m < 4; ++m) _Pragma("unroll") for (int n = 0; n < 2; ++n) _Pragma("unroll") for (int k = 0; k < 2; ++k) \
        acc[ai][bj][m][n] = __builtin_amdgcn_mfma_f32_16x16x32_bf16(Bt[n][k], At[m][k], acc[ai][bj][m][n], 0, 0, 0); __builtin_amdgcn_s_setprio(0); } while (0)
#define PG8_WAIT_V(n) asm volatile("s_waitcnt vmcnt(" #n ")" ::: "memory")
#define PG8_WAIT_L(n) asm volatile("s_waitcnt lgkmcnt(" #n ")" ::: "memory")
#define PG8_BAR __builtin_amdgcn_s_barrier()
#define PG8_SCHED __builtin_amdgcn_sched_barrier(0)
    Unit cur, nxt; int ui = 0;
    if (!S.next(0, cur)) return;
    f32x4 acc[2][2][4][2];
#pragma unroll
    for (int a = 0; a < 2; ++a)
#pragma unroll
        for (int b = 0; b < 2; ++b)
#pragma unroll
            for (int m = 0; m < 4; ++m)
#pragma unroll
                for (int n = 0; n < 2; ++n) acc[a][b][m][n] = (f32x4){0.f, 0.f, 0.f, 0.f};
    bf16x8 At[4][2], B0[2][2], B1[2][2];
    const char* cA = (const char*)g.A + (size_t)cur.pm * tstep + (size_t)cur.kofs * 2; const char* cB = (const char*)g.Bt + (size_t)cur.pn * tstep + (size_t)cur.kofs * 2;
    S.a_ready(cur);
    if constexpr (SP2) {
        PG8_STAGE(PG8_SB(0, 0), cB, voffB); PG8_STAGE(PG8_SB(0, 1), cB + hstep, voffB); PG8_STAGE(PG8_SA(0, 0), cA, voffA); PG8_STAGE(PG8_SA(0, 1), cA + hstep, voffA);
        if (wr == 1) PG8_BAR;
        PG8_WAIT_V(2); PG8_BAR;
        PG8_STAGE(PG8_SB(1, 0), cB + kstep, voffB); PG8_STAGE(PG8_SA(1, 0), cA + kstep, voffA); PG8_STAGE(PG8_SB(1, 1), cB + hstep + kstep, voffB);
        PG8_WAIT_V(6); PG8_BAR;
    } else {
        PG8_STAGE(PG8_SB(0, 0), cB, voffB); PG8_STAGE(PG8_SA(0, 0), cA, voffA); PG8_STAGE(PG8_SB(0, 1), cB + hstep, voffB); PG8_STAGE(PG8_SA(0, 1), cA + hstep, voffA);
        if (wr == 1) PG8_BAR;
        PG8_WAIT_V(4); PG8_BAR;
        PG8_STAGE(PG8_SB(1, 0), cB + kstep, voffB); PG8_STAGE(PG8_SA(1, 0), cA + kstep, voffA); PG8_STAGE(PG8_SB(1, 1), cB + hstep + kstep, voffB);
        PG8_WAIT_V(6); PG8_BAR;
    }
    for (;;) {
        const bool has_next = S.next(ui + 1, nxt);
        const char* nA = has_next ? (const char*)g.A + (size_t)nxt.pm * tstep + (size_t)nxt.kofs * 2 : cA; const char* nB = has_next ? (const char*)g.Bt + (size_t)nxt.pn * tstep + (size_t)nxt.kofs * 2 : cB;
        for (int t = 0; t < nt; t += 2) {
            const bool last = (t == nt - 2);
            const char* a1 = cA + (size_t)(t + 1) * kstep;
            const char* a2 = last ? nA : cA + (size_t)(t + 2) * kstep; const char* b2 = last ? nB : cB + (size_t)(t + 2) * kstep;
            const char* a3 = a2 + kstep; const char* b3 = b2 + kstep;
            if (last && has_next) S.a_ready(nxt);
            if constexpr (SP2) {
            PG8_LDB(B0, 0, 0); PG8_LDB(B1, 0, 1); PG8_SCHED; PG8_LDA(At, 0, 0); PG8_STAGE(PG8_SA(1, 1), a1 + hstep, voffA);
            PG8_WAIT_V(8); PG8_WAIT_L(0); PG8_BAR; PG8_MMA(0, 0, At, B0); PG8_MMA(0, 1, At, B1); PG8_BAR; PG8_SCHED;
            PG8_LDA(At, 0, 1); PG8_STAGE(PG8_SB(0, 0), b2, voffB); PG8_STAGE(PG8_SB(0, 1), b2 + hstep, voffB); PG8_STAGE(PG8_SA(0, 0), a2, voffA);
            PG8_WAIT_V(8); PG8_WAIT_L(0); PG8_BAR; PG8_MMA(1, 0, At, B0); PG8_MMA(1, 1, At, B1); PG8_BAR; PG8_SCHED;
            PG8_LDB(B0, 1, 0); PG8_LDB(B1, 1, 1); PG8_SCHED; PG8_LDA(At, 1, 0); PG8_STAGE(PG8_SA(0, 1), a2 + hstep, voffA);
            PG8_WAIT_V(8); PG8_WAIT_L(0); PG8_BAR; PG8_MMA(0, 0, At, B0); PG8_MMA(0, 1, At, B1); PG8_BAR; PG8_SCHED;
            PG8_LDA(At, 1, 1); PG8_STAGE(PG8_SB(1, 0), b3, voffB); PG8_STAGE(PG8_SB(1, 1), b3 + hstep, voffB); PG8_STAGE(PG8_SA(1, 0), a3, voffA);
            PG8_WAIT_V(8); PG8_WAIT_L(0); PG8_BAR; PG8_MMA(1, 0, At, B0); PG8_MMA(1, 1, At, B1); PG8_BAR; PG8_SCHED;
            } else {
            PG8_LDB(B0, 0, 0); PG8_SCHED; PG8_LDA(At, 0, 0); PG8_STAGE(PG8_SA(1, 1), a1 + hstep, voffA);
            PG8_WAIT_L(8); PG8_BAR; PG8_WAIT_L(0); PG8_MMA(0, 0, At, B0); PG8_BAR; PG8_SCHED;
            PG8_LDB(B1, 0, 1); PG8_STAGE(PG8_SB(0, 0), b2, voffB);
            PG8_BAR; PG8_WAIT_L(0); PG8_MMA(0, 1, At, B1); PG8_BAR;
            PG8_LDA(At, 0, 1); PG8_STAGE(PG8_SA(0, 0), a2, voffA);
            PG8_BAR; PG8_WAIT_L(0); PG8_MMA(1, 0, At, B0); PG8_BAR; PG8_SCHED;
            PG8_STAGE(PG8_SB(0, 1), b2 + hstep, voffB);
            PG8_WAIT_V(6); PG8_BAR; PG8_MMA(1, 1, At, B1); PG8_BAR;
            PG8_LDB(B0, 1, 0); PG8_SCHED; PG8_LDA(At, 1, 0); PG8_STAGE(PG8_SA(0, 1), a2 + hstep, voffA);
            PG8_WAIT_L(8); PG8_BAR; PG8_WAIT_L(0); PG8_MMA(0, 0, At, B0); PG8_BAR; PG8_SCHED;
            PG8_LDB(B1, 1, 1); PG8_STAGE(PG8_SB(1, 0), b3, voffB);
            PG8_BAR; PG8_WAIT_L(0); PG8_MMA(0, 1, At, B1); PG8_BAR;
            PG8_LDA(At, 1, 1); PG8_STAGE(PG8_SA(1, 0), a3, voffA);
            PG8_BAR; PG8_WAIT_L(0); PG8_MMA(1, 0, At, B0); PG8_BAR; PG8_SCHED;
            PG8_STAGE(PG8_SB(1, 1), b3 + hstep, voffB);
            PG8_WAIT_V(6); PG8_BAR; PG8_MMA(1, 1, At, B1); PG8_BAR;
            }
        }
        if constexpr (ALIGN_EPI) { if (wr == 0) PG8_BAR; }
        if constexpr (!Epi::AFTER_DRAIN) { E(acc, cur, wr, wc, fr, fq); S.done(cur); }
        if (!has_next) break;
#pragma unroll
        for (int a = 0; a < 2; ++a)
#pragma unroll
            for (int b = 0; b < 2; ++b)
#pragma unroll
                for (int m = 0; m < 4; ++m)
#pragma unroll
                    for (int n = 0; n < 2; ++n) acc[a][b][m][n] = (f32x4){0.f, 0.f, 0.f, 0.f};
        cur = nxt; cA = nA; cB = nB; ++ui;
        if constexpr (ALIGN_EPI) { if (wr == 1) PG8_BAR; }
    }
    PG8_WAIT_V(0);
    if constexpr (!ALIGN_EPI) { if (wr == 0) PG8_BAR; }
    PG8_BAR;
    if constexpr (Epi::AFTER_DRAIN) { E.fused(acc, cur, wr, wc, fr, fq, lds, wid, lane); S.done(cur); }
#undef PG8_SA
#undef PG8_SB
#undef PG8_STAGE
#undef PG8_LDA
#undef PG8_LDB
#undef PG8_MMA
#undef PG8_WAIT_V
#undef PG8_WAIT_L
#undef PG8_BAR
#undef PG8_SCHED
}
}

#define LAS __attribute__((address_space(3)))
typedef unsigned short bf16_t;
typedef short bf16x8 __attribute__((ext_vector_type(8)));
typedef float f32x4 __attribute__((ext_vector_type(4)));
typedef float f32x16 __attribute__((ext_vector_type(16)));
typedef unsigned u32x4 __attribute__((ext_vector_type(4)));
typedef unsigned u32x2 __attribute__((ext_vector_type(2)));

constexpr int DM = 1024, TPROMPT = 16384, TSAMPLE = 1024, MROWS = TPROMPT + TSAMPLE;
constexpr int NBB = 18;
constexpr int DFF = 2816, PAST = 4096;
constexpr float EPSV = 1e-6f;
constexpr size_t O_YP = 0, O_YS = 16777216, O_KP = 17825792, O_VP = 26214400, O_SP = 34603008, O_CP = 34734080, O_HP = 34740224,
                 O_KS = 34742272, O_VS = 35266560, O_SS = 35790848, O_CS = 36839424, O_HS = 36888576, O_END = 36904960;
constexpr size_t MiB = 1u << 20;
constexpr size_t WS_MOD = 1 * MiB;
constexpr size_t WS_LB = 2 * MiB;
constexpr size_t WS_WLRU = 2 * MiB + 65536;
constexpr size_t WS_WINE = 3 * MiB;
constexpr size_t WS_WOUTE = 10 * MiB;
constexpr size_t WS_WINO = 12 * MiB;
constexpr size_t WS_WOUTO = 16 * MiB;
constexpr size_t WS_WGU = 18 * MiB;
constexpr size_t WS_WD = 40 * MiB;
constexpr size_t WS_ABUF = 52 * MiB;
constexpr size_t WS_X = 86 * MiB;
constexpr size_t WS_ACT = 154 * MiB;
constexpr size_t WS_UT = WS_ACT, WS_QT = WS_ACT + 70 * MiB;
constexpr size_t WS_P = 248 * MiB;
constexpr size_t WS_QA = WS_P, WS_QB = WS_P + 17 * MiB, WS_KB = WS_P + 34 * MiB, WS_IB = WS_P + 51 * MiB, WS_GB = WS_P + 68 * MiB, WS_LF = WS_P + 85 * MiB;
constexpr size_t WS_GG = WS_P, WS_XBR = WS_P + 34 * MiB, WS_AGGA = WS_P + 102 * MiB, WS_AGGH = WS_P + 104 * MiB;
constexpr size_t WS_LAB = WS_ACT, WS_UUB = WS_ACT + 34 * MiB;
constexpr size_t WS_PART = 368 * MiB;
constexpr size_t WS_OI = 368 * MiB;
constexpr size_t WS_SNT = 402 * MiB;
constexpr size_t WS_DEC = 436 * MiB;
constexpr size_t WS_VT = 438 * MiB;
constexpr size_t WS_KBF = 455 * MiB;
constexpr size_t WS_ABUF2 = 472 * MiB;
constexpr size_t WS_SLOTS = 262144;
constexpr size_t WS_CNT = 32768;
constexpr size_t WS_END = 506 * MiB;
static_assert(WS_QT + (size_t)MROWS * 512 * 2 <= WS_P && WS_LF + (size_t)MROWS * 512 * 4 <= WS_OI && WS_ACT + (size_t)MROWS * DFF * 2 <= WS_P, "ws map");
static_assert(WS_UT + (size_t)1088 * 16384 * 4 <= WS_QT && WS_AGGH + 272 * 1024 * 4 <= WS_OI && WS_X + (size_t)MROWS * 1024 * 4 <= WS_ACT, "ws map 2");

constexpr int NWAVES = 8, NTHREADS = 512;
constexpr int RING_BYTES = 131072, LDS_BYTES = 147456;

#define LDS_WAIT() asm volatile("s_waitcnt lgkmcnt(0)" ::: "memory")
#define LBAR() do { asm volatile("s_waitcnt lgkmcnt(0)" ::: "memory"); __builtin_amdgcn_s_barrier(); asm volatile("" ::: "memory"); } while (0)
__device__ __forceinline__ unsigned pk2(float lo, float hi) { return pg8::cvt_pk_bf16(lo, hi); }
__device__ __forceinline__ float bflo(unsigned w) { return __uint_as_float(w << 16); }
__device__ __forceinline__ float bfhi(unsigned w) { return __uint_as_float(w & 0xffff0000u); }
__device__ __forceinline__ float sigm(float x) { return __builtin_amdgcn_rcpf(1.f + __expf(-x)); }
__device__ __forceinline__ float silu_(float x) { return x * __builtin_amdgcn_rcpf(1.f + __expf(-x)); }
__device__ __forceinline__ float gelu_tanh(float x) { const float u = 0.7978845608028654f * (x + 0.044715f * x * x * x); const float t = 1.f - 2.f * __builtin_amdgcn_rcpf(1.f + __expf(2.f * u)); return 0.5f * x * (1.f + t); }
__device__ __forceinline__ float wave_sum(float v) {
#pragma unroll
    for (int o = 1; o < 64; o <<= 1) v += __shfl_xor(v, o);
    return v;
}
__device__ __forceinline__ bf16x8 cvt8(const f32x4 a, const f32x4 b) {
    u32x4 w; w.x = pk2(a.x, a.y); w.y = pk2(a.z, a.w); w.z = pk2(b.x, b.y); w.w = pk2(b.z, b.w); return __builtin_bit_cast(bf16x8, w);
}
__device__ __forceinline__ int row_bb(int row) { return row < TPROMPT ? (row >> 13) : 2 + ((row - TPROMPT) >> 6); }

struct Args { const float* in[30]; float* out; unsigned char* ws; int ph_lo, ph_hi; };
typedef const __attribute__((address_space(4))) Args* KA;
__device__ __forceinline__ KA kargs() { KA p = (KA)__builtin_amdgcn_kernarg_segment_ptr(); asm volatile("" : "+s"(p)); return p; }

struct EpiInEven {
    static constexpr bool PERM = true, AFTER_DRAIN = false;
    float* out; bf16_t *QA, *QB, *KB, *IB, *GB; float* LF; const float* LB; bf16_t *KBF, *VT;
    __device__ __forceinline__ void operator()(const f32x4 (&acc)[2][2][4][2], const pg8::Unit& u, int wr, int wc, int fr, int fq) const {
        const int typ = u.pn >> 1;
        const int cb = (u.pn & 1) * 256 + wc * 32 + 8 * fq;
#pragma unroll
        for (int ai = 0; ai < 2; ++ai)
#pragma unroll
            for (int m = 0; m < 4; ++m) {
                const int row = u.pm * 256 + ai * 128 + wr * 64 + m * 16 + fr;
#pragma unroll
                for (int bj = 0; bj < 2; ++bj) {
                    const int cc = cb + bj * 128;
                    f32x4 v0 = acc[ai][bj][m][0], v1 = acc[ai][bj][m][1];
                    if (typ == 1 || typ == 2) {
                        float* dst = (row < TPROMPT) ? out + (typ == 1 ? O_KP : O_VP) + (size_t)row * 512 : out + (typ == 1 ? O_KS : O_VS) + (size_t)(row - TPROMPT) * 512;
                        *(f32x4*)(dst + cc) = v0; *(f32x4*)(dst + cc + 4) = v1;
                        if (typ == 1) { u32x4 w; w.x = pk2(v0[0], v0[1]); w.y = pk2(v0[2], v0[3]); w.z = pk2(v1[0], v1[1]); w.w = pk2(v1[2], v1[3]); *(u32x4*)(KBF + (size_t)row * 512 + cc) = w; }
                        else {
                            const int hh = cc >> 6, d0 = cc & 63;
                            bf16_t* vt; int tt;
                            if (row < TPROMPT) { tt = row & 8191; vt = VT + ((size_t)((row >> 13) * 8 + hh) * 64 + d0) * 8192; }
                            else { const int sr = row - TPROMPT; tt = sr & 63; vt = VT + (size_t)16 * 64 * 8192 + ((size_t)((sr >> 6) * 8 + hh) * 64 + d0) * 64; }
                            const int T = (row < TPROMPT) ? 8192 : 64;
                            const int pos = (tt & ~12) | ((tt & 4) << 1) | ((tt & 8) >> 1);
#pragma unroll
                            for (int e = 0; e < 4; ++e) { vt[(size_t)e * T + pos] = (bf16_t)(pk2(v0[e], 0.f) & 0xffffu); vt[(size_t)(4 + e) * T + pos] = (bf16_t)(pk2(v1[e], 0.f) & 0xffffu); }
                        }
                    } else if (typ == 4) {
                        const f32x4 l0 = *(const f32x4*)(LB + cc), l1 = *(const f32x4*)(LB + cc + 4);
                        f32x4 lf0, lf1, k0, k1;
#pragma unroll
                        for (int e = 0; e < 4; ++e) {
                            const float s0 = sigm(v0[e]), s1 = sigm(v1[e]);
                            lf0[e] = __logf(l0[e] + (1.f - l0[e]) * s0); lf1[e] = __logf(l1[e] + (1.f - l1[e]) * s1);
                            k0[e] = (1.f - l0[e]) * (1.f - s0); k1[e] = (1.f - l1[e]) * (1.f - s1);
                        }
                        *(f32x4*)(LF + (size_t)row * 512 + cc) = lf0; *(f32x4*)(LF + (size_t)row * 512 + cc + 4) = lf1;
                        u32x4 w; w.x = pk2(k0[0], k0[1]); w.y = pk2(k0[2], k0[3]); w.z = pk2(k1[0], k1[1]); w.w = pk2(k1[2], k1[3]);
                        *(u32x4*)(KB + (size_t)row * 512 + cc) = w;
                    } else {
                        bf16_t* dst = (typ == 0) ? QA : (typ == 3) ? QB : (typ == 5) ? IB : GB;
                        if (typ == 0) { v0 = v0 * 0.18033688f; v1 = v1 * 0.18033688f; }
                        else if (typ == 3) {
#pragma unroll
                            for (int e = 0; e < 4; ++e) { v0[e] = silu_(v0[e]) * 0.08838834764831845f; v1[e] = silu_(v1[e]) * 0.08838834764831845f; }
                        } else if (typ == 6) {
#pragma unroll
                            for (int e = 0; e < 4; ++e) { v0[e] = silu_(v0[e]); v1[e] = silu_(v1[e]); }
                        }
                        u32x4 w; w.x = pk2(v0[0], v0[1]); w.y = pk2(v0[2], v0[3]); w.z = pk2(v1[0], v1[1]); w.w = pk2(v1[2], v1[3]);
                        *(u32x4*)(dst + (size_t)row * 512 + cc) = w;
                    }
                }
            }
    }
};
struct EpiGU {
    static constexpr bool PERM = true, AFTER_DRAIN = false;
    bf16_t* ACT;
    __device__ __forceinline__ void operator()(const f32x4 (&acc)[2][2][4][2], const pg8::Unit& u, int wr, int wc, int fr, int fq) const {
        const int col = u.pn * 128 + wc * 32 + 8 * fq;
#pragma unroll
        for (int ai = 0; ai < 2; ++ai)
#pragma unroll
            for (int m = 0; m < 4; ++m) {
                const int row = u.pm * 256 + ai * 128 + wr * 64 + m * 16 + fr;
                const f32x4 g0 = acc[ai][0][m][0], g1 = acc[ai][0][m][1], u0 = acc[ai][1][m][0], u1 = acc[ai][1][m][1];
                float a[8];
#pragma unroll
                for (int e = 0; e < 4; ++e) { a[e] = silu_(g0[e]) * u0[e]; a[4 + e] = silu_(g1[e]) * u1[e]; }
                u32x4 w; w.x = pk2(a[0], a[1]); w.y = pk2(a[2], a[3]); w.z = pk2(a[4], a[5]); w.w = pk2(a[6], a[7]);
                *(u32x4*)(ACT + (size_t)row * DFF + col) = w;
            }
    }
};
struct EpiRes {
    static constexpr bool PERM = true, AFTER_DRAIN = false;
    const float* xoldP; const float* xoldS; float* xnew; const float* gate;
    __device__ __forceinline__ void operator()(const f32x4 (&acc)[2][2][4][2], const pg8::Unit& u, int wr, int wc, int fr, int fq) const {
#pragma unroll
        for (int ai = 0; ai < 2; ++ai) {
            const int bb = (u.pm < 64) ? (u.pm >> 5) : 2 + (u.pm - 64) * 4 + 2 * ai + wr;
#pragma unroll
            for (int bj = 0; bj < 2; ++bj) {
                const int col = u.pn * 256 + bj * 128 + wc * 32 + 8 * fq;
                const f32x4 g0 = *(const f32x4*)(gate + (size_t)bb * 6144 + col) + 1.f, g1 = *(const f32x4*)(gate + (size_t)bb * 6144 + col + 4) + 1.f;
#pragma unroll
                for (int m = 0; m < 4; ++m) {
                    const int row = u.pm * 256 + ai * 128 + wr * 64 + m * 16 + fr;
                    const float* xo = ((row < TPROMPT) ? xoldP + (size_t)row * DM : xoldS + (size_t)(row - TPROMPT) * DM) + col;
                    float* xn = xnew + (size_t)row * DM + col;
                    const f32x4 a = *(const f32x4*)xo, b = *(const f32x4*)(xo + 4);
                    *(f32x4*)xn = a + g0 * acc[ai][bj][m][0]; *(f32x4*)(xn + 4) = b + g1 * acc[ai][bj][m][1];
                }
            }
        }
    }
};
template <int NSPLIT> struct SplitOrder {
    int G, c;
    __device__ __forceinline__ bool next(int i, pg8::Unit& u) const { const int L = i * G + c; if (L >= 16 * NSPLIT) return false; const int j = L / NSPLIT, sp = L - j * NSPLIT; u.pm = 64 + (j >> 2); u.pn = j & 3; u.kofs = sp * 256; return true; }
    __device__ __forceinline__ void a_ready(const pg8::Unit&) const {}
    __device__ __forceinline__ void done(const pg8::Unit&) const {}
};
struct EpiPart {
    static constexpr bool PERM = true, AFTER_DRAIN = false;
    float* PART;
    __device__ __forceinline__ void operator()(const f32x4 (&acc)[2][2][4][2], const pg8::Unit& u, int wr, int wc, int fr, int fq) const {
        const int sp = u.kofs >> 8;
        float* base = PART + (size_t)sp * TSAMPLE * DM;
#pragma unroll
        for (int ai = 0; ai < 2; ++ai)
#pragma unroll
            for (int m = 0; m < 4; ++m) { const int row = (u.pm - 64) * 256 + ai * 128 + wr * 64 + m * 16 + fr;
#pragma unroll
                for (int bj = 0; bj < 2; ++bj) { const int col = u.pn * 256 + bj * 128 + wc * 32 + 8 * fq;
                    *(f32x4*)(base + (size_t)row * DM + col) = acc[ai][bj][m][0]; *(f32x4*)(base + (size_t)row * DM + col + 4) = acc[ai][bj][m][1]; } }
    }
};
template <bool FIN, bool XBF> struct EpiResNorm {
    static constexpr bool PERM = true, AFTER_DRAIN = true;
    const void* xold; bf16_t* Xw; const float* gate; const float* g; const float* sc; const float* sh; bf16_t* HN; float* OUT; float* slots; unsigned* cnt;
    __device__ __forceinline__ void fused(f32x4 (&acc)[2][2][4][2], const pg8::Unit& u, int wr, int wc, int fr, int fq, PG8_LAS unsigned char* lds, int wid, int lane) const {
        PG8_LAS float* P = (PG8_LAS float*)lds;
        PG8_LAS float* S = (PG8_LAS float*)(lds + 8192);
        const int bb = u.pm >> 5, colb = u.pn * 256 + wc * 32 + 8 * fq;
        {
            f32x4 g4[2][2];
#pragma unroll
            for (int bj = 0; bj < 2; ++bj)
#pragma unroll
                for (int n = 0; n < 2; ++n) g4[bj][n] = *(const f32x4*)(gate + (size_t)bb * 6144 + colb + bj * 128 + 4 * n) + 1.f;
#pragma unroll
            for (int ai = 0; ai < 2; ++ai)
#pragma unroll
                for (int m = 0; m < 4; ++m) { const size_t off = (size_t)(u.pm * 256 + ai * 128 + wr * 64 + m * 16 + fr) * DM + colb; const float* xr = (const float*)xold + off; const bf16_t* xrb = (const bf16_t*)xold + off; bf16_t* xw = Xw + off;
#pragma unroll
                    for (int bj = 0; bj < 2; ++bj) { f32x4 xo0, xo1;
                        if (XBF) { const u32x4 w = *(const u32x4*)(xrb + bj * 128); xo0 = (f32x4){bflo(w.x), bfhi(w.x), bflo(w.y), bfhi(w.y)}; xo1 = (f32x4){bflo(w.z), bfhi(w.z), bflo(w.w), bfhi(w.w)}; }
                        else { xo0 = *(const f32x4*)(xr + bj * 128); xo1 = *(const f32x4*)(xr + bj * 128 + 4); }
                        const f32x4 xn0 = xo0 + g4[bj][0] * acc[ai][bj][m][0], xn1 = xo1 + g4[bj][1] * acc[ai][bj][m][1]; acc[ai][bj][m][0] = xn0; acc[ai][bj][m][1] = xn1;
                        if (!FIN) { u32x4 w; w.x = pk2(xn0.x, xn0.y); w.y = pk2(xn0.z, xn0.w); w.z = pk2(xn1.x, xn1.y); w.w = pk2(xn1.z, xn1.w); *(u32x4*)(xw + bj * 128) = w; } }
                    asm volatile("" : "+v"(acc[ai][0][m][0]), "+v"(acc[ai][0][m][1]), "+v"(acc[ai][1][m][0]), "+v"(acc[ai][1][m][1]));
                    asm volatile("" ::: "memory"); }
        }
#pragma unroll
        for (int ai = 0; ai < 2; ++ai)
#pragma unroll
            for (int m = 0; m < 4; ++m) { float q = 0.f;
#pragma unroll
                for (int bj = 0; bj < 2; ++bj)
#pragma unroll
                    for (int n = 0; n < 2; ++n) { const f32x4 x = acc[ai][bj][m][n]; q += (x[0] * x[0] + x[1] * x[1]) + (x[2] * x[2] + x[3] * x[3]); }
                q += __shfl_xor(q, 16); q += __shfl_xor(q, 32);
                if (fq == 0) P[(ai * 128 + wr * 64 + m * 16 + fr) * 4 + wc] = q; }
        asm volatile("s_waitcnt lgkmcnt(0)" ::: "memory"); __builtin_amdgcn_s_barrier(); asm volatile("" ::: "memory");
        const int row = wid * 32 + (lane & 31);
        if (lane < 32) { const float t = (P[row * 4 + 0] + P[row * 4 + 1]) + (P[row * 4 + 2] + P[row * 4 + 3]);
            __hip_atomic_store(slots + ((size_t)(u.pm * 256 + row) * 4 + u.pn), t, __ATOMIC_RELAXED, __HIP_MEMORY_SCOPE_AGENT); }
        asm volatile("s_waitcnt vmcnt(0)" ::: "memory");
        if (lane == 0) __hip_atomic_fetch_add(cnt + 64 * u.pm, 1u, __ATOMIC_RELAXED, __HIP_MEMORY_SCOPE_AGENT);
        if (wid == 0) { while ((unsigned)__builtin_amdgcn_readfirstlane(__hip_atomic_load(cnt + 64 * u.pm, __ATOMIC_RELAXED, __HIP_MEMORY_SCOPE_AGENT)) < 32u) __builtin_amdgcn_s_sleep(1); }
        asm volatile("s_waitcnt vmcnt(0) lgkmcnt(0)" ::: "memory"); __builtin_amdgcn_s_barrier(); asm volatile("" ::: "memory");
        if (lane < 32) { const float* sl = slots + (size_t)(u.pm * 256 + row) * 4; float t = 0.f;
#pragma unroll
            for (int k = 0; k < 4; ++k) t += __hip_atomic_load(sl + k, __ATOMIC_RELAXED, __HIP_MEMORY_SCOPE_AGENT);
            S[row] = rsqrtf(t * (1.f / DM) + EPSV); }
        asm volatile("s_waitcnt lgkmcnt(0)" ::: "memory"); __builtin_amdgcn_s_barrier(); asm volatile("" ::: "memory");
#pragma unroll
        for (int bj = 0; bj < 2; ++bj) {
            f32x4 gs[2], s0[2];
#pragma unroll
            for (int n = 0; n < 2; ++n) { const int col = colb + bj * 128 + 4 * n; gs[n] = *(const f32x4*)(g + col); s0[n] = (f32x4){0.f, 0.f, 0.f, 0.f};
                if (!FIN) { gs[n] = gs[n] * (*(const f32x4*)(sc + (size_t)bb * 6144 + col) + 1.f); s0[n] = *(const f32x4*)(sh + (size_t)bb * 6144 + col); } }
#pragma unroll
            for (int ai = 0; ai < 2; ++ai)
#pragma unroll
                for (int m = 0; m < 4; ++m) { const int r = ai * 128 + wr * 64 + m * 16 + fr; const size_t off = (size_t)(u.pm * 256 + r) * DM + colb + bj * 128; const float rs = S[r];
                    const f32x4 y0 = acc[ai][bj][m][0] * rs * gs[0] + s0[0], y1 = acc[ai][bj][m][1] * rs * gs[1] + s0[1];
                    if (!FIN) { u32x4 w; w.x = pk2(y0.x, y0.y); w.y = pk2(y0.z, y0.w); w.z = pk2(y1.x, y1.y); w.w = pk2(y1.z, y1.w); *(u32x4*)(HN + off) = w; }
                    else { *(f32x4*)(OUT + off) = y0; *(f32x4*)(OUT + off + 4) = y1; }
                    asm volatile("" ::: "memory"); }
        }
        asm volatile("s_waitcnt lgkmcnt(0)" ::: "memory"); __builtin_amdgcn_s_barrier(); asm volatile("" ::: "memory");
    }
};
struct EpiInOdd {
    static constexpr bool PERM = true, AFTER_DRAIN = false;
    bf16_t* GG; float* XBR;
    __device__ __forceinline__ void operator()(const f32x4 (&acc)[2][2][4][2], const pg8::Unit& u, int wr, int wc, int fr, int fq) const {
        const int typ = u.pn >> 2;
        const int cb = (u.pn & 3) * 256 + wc * 32 + 8 * fq;
#pragma unroll
        for (int ai = 0; ai < 2; ++ai)
#pragma unroll
            for (int m = 0; m < 4; ++m) {
                const int row = u.pm * 256 + ai * 128 + wr * 64 + m * 16 + fr;
#pragma unroll
                for (int bj = 0; bj < 2; ++bj) {
                    const int cc = cb + bj * 128;
                    f32x4 v0 = acc[ai][bj][m][0], v1 = acc[ai][bj][m][1];
                    if (typ == 0) {
#pragma unroll
                        for (int e = 0; e < 4; ++e) { v0[e] = gelu_tanh(v0[e]); v1[e] = gelu_tanh(v1[e]); }
                        u32x4 w; w.x = pk2(v0[0], v0[1]); w.y = pk2(v0[2], v0[3]); w.z = pk2(v1[0], v1[1]); w.w = pk2(v1[2], v1[3]);
                        *(u32x4*)(GG + (size_t)row * DM + cc) = w;
                    } else { *(f32x4*)(XBR + (size_t)row * DM + cc) = v0; *(f32x4*)(XBR + (size_t)row * DM + cc + 4) = v1; }
                }
            }
    }
};

__device__ __forceinline__ void transpose_item(const float* W, int K, int N, bf16_t* WT, int n0, int k0, size_t drow0, LAS float* scr, int lane) {
#pragma unroll 8
    for (int i = 0; i < 32; ++i) { const int kk = 2 * i + (lane >> 5); scr[kk * 33 + (lane & 31)] = W[(size_t)(k0 + kk) * N + n0 + (lane & 31)]; }
    LDS_WAIT(); asm volatile("" ::: "memory");
    const int c = lane & 7;
#pragma unroll
    for (int j = 0; j < 4; ++j) { const int n = (lane >> 3) + 8 * j; const LAS float* s = scr + (8 * c) * 33 + n;
        u32x4 o; o.x = pk2(s[0 * 33], s[1 * 33]); o.y = pk2(s[2 * 33], s[3 * 33]); o.z = pk2(s[4 * 33], s[5 * 33]); o.w = pk2(s[6 * 33], s[7 * 33]);
        *(u32x4*)(WT + (drow0 + n) * (size_t)K + k0 + 8 * c) = o; }
    LDS_WAIT(); asm volatile("" ::: "memory");
}
template <int SET> __device__ __forceinline__ void convert_set(KA A, LAS unsigned char* lds, int lane, int wave, int widx, int nworkers) {
    unsigned char* ws = A->ws;
    LAS float* scr = (LAS float*)(lds + wave * 16384);
#define TJOB(Wp, Kk, Nn, WTp, MODE) { const int cnt = ((Kk) / 64) * ((Nn) / 32); if (r < cnt) { const int nblk = (Nn) / 32, kb_ = r / nblk, nb_ = r % nblk, n0_ = nb_ * 32; \
        const size_t drow_ = (MODE) == 0 ? (size_t)n0_ : (size_t)(256 * (n0_ / 128) + (n0_ % 128) + ((MODE) == 2 ? 128 : 0)); \
        transpose_item((Wp), (Kk), (Nn), (WTp), n0_, kb_ * 64, drow_, scr, lane); continue; } r -= cnt; }
    constexpr int NIT = SET == 0 ? 16 * 112 + 2 * 16 * 88 : SET == 1 ? 16 * 32 + 16 * 64 : SET == 2 ? 44 * 32 : 16 * 32 + 2 * 16 * 88 + 44 * 32 + 16 * 8;
    for (int it = widx; it < NIT; it += nworkers) {
        int r = it;
        if (SET == 0) {
            TJOB(A->in[13], 1024, 3584, (bf16_t*)(ws + WS_WINE), 0)
            TJOB(A->in[26], 1024, 2816, (bf16_t*)(ws + WS_WGU), 1)
            TJOB(A->in[27], 1024, 2816, (bf16_t*)(ws + WS_WGU), 2)
        } else if (SET == 1) {
            TJOB(A->in[14], 1024, 1024, (bf16_t*)(ws + WS_WOUTE), 0)
            TJOB(A->in[17], 1024, 2048, (bf16_t*)(ws + WS_WINO), 0)
        } else if (SET == 2) {
            TJOB(A->in[28], 2816, 1024, (bf16_t*)(ws + WS_WD), 0)
        } else {
            TJOB(A->in[25], 1024, 1024, (bf16_t*)(ws + WS_WOUTO), 0)
            TJOB(A->in[26] + (size_t)1024 * 2816, 1024, 2816, (bf16_t*)(ws + WS_WGU) + (size_t)5632 * 1024, 1)
            TJOB(A->in[27] + (size_t)1024 * 2816, 1024, 2816, (bf16_t*)(ws + WS_WGU) + (size_t)5632 * 1024, 2)
            TJOB(A->in[28] + (size_t)2816 * 1024, 2816, 1024, (bf16_t*)(ws + WS_WD) + (size_t)1024 * 2816, 0)
            { const int h = r >> 3, q = r & 7;
              const float* Wp = (h < 8 ? A->in[20] : A->in[22]) + (size_t)(h & 7) * 16384;
              transpose_item(Wp, 128, 128, (bf16_t*)(ws + WS_WLRU) + (size_t)h * 16384, (q & 3) * 32, (q >> 2) * 64, (size_t)((q & 3) * 32), scr, lane); }
        }
    }
#undef TJOB
}
__device__ __forceinline__ void prologue_phase(KA A, LAS unsigned char* lds, int tid, int lane, int wave) {
    unsigned char* ws = A->ws;
    {
        LAS float* sc = (LAS float*)lds;
        LAS float* red = (LAS float*)(lds + 73728);
        float* MOD = (float*)(ws + WS_MOD);
        bool have_sc = false;
        for (int g = blockIdx.x; g < 192; g += gridDim.x) {
            if (!have_sc) {
                for (int i = tid; i < NBB * 1024; i += NTHREADS) { const int bb = i >> 10, k = i & 1023; const float c = bb < 2 ? A->in[7][bb * 1024 + k] : A->in[8][(bb - 2) * 1024 + k]; sc[i] = silu_(c); }
                have_sc = true;
            }
            __syncthreads();
            const int l = g / 96, cg0 = (g % 96) * 64;
            const float* W = A->in[11] + (size_t)l * 1024 * 6144 + cg0 + lane;
            float acc[NBB];
#pragma unroll
            for (int b = 0; b < NBB; ++b) acc[b] = 0.f;
            const int kb = wave * 128;
#pragma unroll 4
            for (int k4 = 0; k4 < 128; k4 += 4) {
                const float w0 = W[(size_t)(kb + k4) * 6144], w1 = W[(size_t)(kb + k4 + 1) * 6144], w2 = W[(size_t)(kb + k4 + 2) * 6144], w3 = W[(size_t)(kb + k4 + 3) * 6144];
#pragma unroll
                for (int b = 0; b < NBB; ++b) { const f32x4 s = *(const LAS f32x4*)(sc + b * 1024 + kb + k4); acc[b] += s.x * w0 + s.y * w1 + s.z * w2 + s.w * w3; }
            }
#pragma unroll
            for (int b = 0; b < NBB; ++b) red[(wave * NBB + b) * 64 + lane] = acc[b];
            __syncthreads();
            for (int o = tid; o < NBB * 64; o += NTHREADS) { const int bb = o >> 6, cl = o & 63; float s = A->in[12][l * 6144 + cg0 + cl];
#pragma unroll
                for (int w = 0; w < 8; ++w) s += red[(w * NBB + bb) * 64 + cl];
                MOD[(size_t)(l * NBB + bb) * 6144 + cg0 + cl] = s; }
        }
        __syncthreads();
    }
    if (blockIdx.x == gridDim.x - 1) {
        const float* lg = A->in[16]; const int c = tid;
        const float a = lg[c], b = lg[512 + c], d = lg[1024 + c], m = fmaxf(a, fmaxf(b, d));
        const float ea = __expf(a - m), eb = __expf(b - m), ed = __expf(d - m);
        ((float*)(ws + WS_LB))[c] = ea / (ea + eb + ed);
    }
    if (gridDim.x > 192) { const int nw = ((int)gridDim.x + ((int)gridDim.x - 192)) * NWAVES;
        convert_set<0>(A, lds, lane, wave, blockIdx.x * NWAVES + wave, nw);
        if (blockIdx.x >= 192) convert_set<0>(A, lds, lane, wave, ((int)gridDim.x + ((int)blockIdx.x - 192)) * NWAVES + wave, nw); }
    else convert_set<0>(A, lds, lane, wave, blockIdx.x * NWAVES + wave, gridDim.x * NWAVES);
}
template <int SET> __device__ __forceinline__ void convert_in_slack(KA A, LAS unsigned char* lds, int lane, int wave, int nwg) {
    const int G = gridDim.x, maxu = (nwg + G - 1) / G, c0 = nwg - (maxu - 1) * G;
    if (c0 >= G) convert_set<SET>(A, lds, lane, wave, blockIdx.x * NWAVES + wave, G * NWAVES);
    else if ((int)blockIdx.x >= c0) convert_set<SET>(A, lds, lane, wave, ((int)blockIdx.x - c0) * NWAVES + wave, (G - c0) * NWAVES);
}

constexpr int NRB = 4;
__device__ __forceinline__ void norm_mod_phase(const float* xP, const float* xS, const float* g, const float* modl, int shift_i, int scale_i, bf16_t* outb, int lane, int wave,
                                               const float* part, int nsplit, const float* gatev, float* Xs, bool do_prompt, int sgw, int sngw) {
    const int gw = blockIdx.x * NWAVES + wave, NGW = gridDim.x * NWAVES;
    if (do_prompt) for (int row0 = gw * NRB; row0 < TPROMPT; row0 += NGW * NRB) {
        f32x4 v[NRB][4]; float ss[NRB];
#pragma unroll
        for (int r = 0; r < NRB; ++r) { const float* xr = xP + (size_t)(row0 + r) * DM;
#pragma unroll
            for (int j = 0; j < 4; ++j) v[r][j] = *(const f32x4*)(xr + 4 * (lane + 64 * j)); }
        const int bb = row0 >> 13;
        const float* sh = modl + (size_t)bb * 6144 + shift_i * 1024; const float* sc = modl + (size_t)bb * 6144 + scale_i * 1024;
        f32x4 gs[4], s0[4];
#pragma unroll
        for (int j = 0; j < 4; ++j) { const int idx = 4 * (lane + 64 * j); gs[j] = *(const f32x4*)(g + idx) * (*(const f32x4*)(sc + idx) + 1.f); s0[j] = *(const f32x4*)(sh + idx); }
#pragma unroll
        for (int r = 0; r < NRB; ++r) { float a = 0.f;
#pragma unroll
            for (int j = 0; j < 4; ++j) a += (v[r][j].x * v[r][j].x + v[r][j].y * v[r][j].y) + (v[r][j].z * v[r][j].z + v[r][j].w * v[r][j].w);
            ss[r] = a; }
#pragma unroll
        for (int o = 1; o < 64; o <<= 1) {
#pragma unroll
            for (int r = 0; r < NRB; ++r) ss[r] += __shfl_xor(ss[r], o); }
#pragma unroll
        for (int r = 0; r < NRB; ++r) { const float rstd = rsqrtf(ss[r] * (1.f / DM) + EPSV);
#pragma unroll
            for (int j = 0; j < 4; ++j) { const int idx = 4 * (lane + 64 * j);
                const f32x4 y = v[r][j] * rstd * gs[j] + s0[j];
                u32x2 w; w.x = pk2(y.x, y.y); w.y = pk2(y.z, y.w);
                *(u32x2*)(outb + (size_t)(row0 + r) * DM + idx) = w; } }
    }
    for (int sr = sgw; sr < TSAMPLE; sr += sngw) {
        const int bb = 2 + (sr >> 6);
        f32x4 v[4], pa[4];
#pragma unroll
        for (int j = 0; j < 4; ++j) { v[j] = *(const f32x4*)(xS + (size_t)sr * DM + 4 * (lane + 64 * j)); pa[j] = (f32x4){0.f, 0.f, 0.f, 0.f}; }
        for (int sp0 = 0; sp0 < nsplit; sp0 += 4) {
            f32x4 pv[4][4];
#pragma unroll
            for (int q = 0; q < 4; ++q) { const int sp = (sp0 + q < nsplit) ? sp0 + q : sp0;
#pragma unroll
                for (int j = 0; j < 4; ++j) pv[q][j] = *(const f32x4*)(part + ((size_t)sp * TSAMPLE + sr) * DM + 4 * (lane + 64 * j)); }
#pragma unroll
            for (int q = 0; q < 4; ++q) if (sp0 + q < nsplit) {
#pragma unroll
                for (int j = 0; j < 4; ++j) pa[j] = pa[j] + pv[q][j]; } }
        if (nsplit > 0) {
#pragma unroll
            for (int j = 0; j < 4; ++j) { const int idx = 4 * (lane + 64 * j); v[j] = v[j] + (*(const f32x4*)(gatev + (size_t)bb * 6144 + idx) + 1.f) * pa[j];
                if (Xs) *(f32x4*)(Xs + (size_t)sr * DM + idx) = v[j]; } }
        float ss = 0.f;
#pragma unroll
        for (int j = 0; j < 4; ++j) ss += (v[j].x * v[j].x + v[j].y * v[j].y) + (v[j].z * v[j].z + v[j].w * v[j].w);
        const float rstd = rsqrtf(wave_sum(ss) * (1.f / DM) + EPSV);
        if (outb) {
            const float* sh = modl + (size_t)bb * 6144 + shift_i * 1024; const float* sc = modl + (size_t)bb * 6144 + scale_i * 1024;
#pragma unroll
            for (int j = 0; j < 4; ++j) { const int idx = 4 * (lane + 64 * j);
                const f32x4 y = v[j] * rstd * (*(const f32x4*)(g + idx)) * (*(const f32x4*)(sc + idx) + 1.f) + *(const f32x4*)(sh + idx);
                u32x2 w; w.x = pk2(y.x, y.y); w.y = pk2(y.z, y.w);
                *(u32x2*)(outb + (size_t)(TPROMPT + sr) * DM + idx) = w; }
        } else {
#pragma unroll
            for (int j = 0; j < 4; ++j) { const int idx = 4 * (lane + 64 * j); *(f32x4*)(Xs + (size_t)sr * DM + idx) = v[j] * rstd * (*(const f32x4*)(g + idx)); }
        }
    }
}
__device__ __forceinline__ void final_norm_phase(const float* X, const float* g, float* out, int lane, int wave) {
    const int gw = blockIdx.x * NWAVES + wave, NGW = gridDim.x * NWAVES;
    for (int row0 = gw * NRB; row0 < TPROMPT; row0 += NGW * NRB) {
        f32x4 v[NRB][4]; float ss[NRB];
#pragma unroll
        for (int r = 0; r < NRB; ++r) {
#pragma unroll
            for (int j = 0; j < 4; ++j) v[r][j] = *(const f32x4*)(X + (size_t)(row0 + r) * DM + 4 * (lane + 64 * j)); }
        f32x4 gs[4];
#pragma unroll
        for (int j = 0; j < 4; ++j) gs[j] = *(const f32x4*)(g + 4 * (lane + 64 * j));
#pragma unroll
        for (int r = 0; r < NRB; ++r) { float a = 0.f;
#pragma unroll
            for (int j = 0; j < 4; ++j) a += (v[r][j].x * v[r][j].x + v[r][j].y * v[r][j].y) + (v[r][j].z * v[r][j].z + v[r][j].w * v[r][j].w);
            ss[r] = a; }
#pragma unroll
        for (int o = 1; o < 64; o <<= 1) {
#pragma unroll
            for (int r = 0; r < NRB; ++r) ss[r] += __shfl_xor(ss[r], o); }
#pragma unroll
        for (int r = 0; r < NRB; ++r) { const int row = row0 + r; const float rstd = rsqrtf(ss[r] * (1.f / DM) + EPSV);
            float* orow = out + O_YP + (size_t)row * DM;
#pragma unroll
            for (int j = 0; j < 4; ++j) { const int idx = 4 * (lane + 64 * j); *(f32x4*)(orow + idx) = v[r][j] * rstd * gs[j]; } }
    }
}

__device__ __forceinline__ int crow(int r, int hi) { return (r & 3) + 8 * (r >> 2) + 4 * hi; }
__device__ __forceinline__ void sb_attn_phase(KA A, int lane, int wave) {
    const int gw = blockIdx.x * NWAVES + wave, NGW = gridDim.x * NWAVES;
    const int r32 = lane & 31, hi = lane >> 5;
    const bf16_t* QA = (const bf16_t*)(A->ws + WS_QA);
    const bf16_t* KBF = (const bf16_t*)(A->ws + WS_KBF);
    const bf16_t* VT = (const bf16_t*)(A->ws + WS_VT);
    bf16_t* OC = (bf16_t*)(A->ws + WS_ABUF);
    const int sblk0 = (gridDim.x >= 128) ? (int)gridDim.x / 4 : 0;
    const int nprompt_it = (4096 - gw + NGW - 1) / NGW;
    const int sfirst = ((int)blockIdx.x - sblk0) * NWAVES + wave, sstride = ((int)gridDim.x - sblk0) * NWAVES;
    const int nsample_it = (sfirst >= 0 && sfirst < 256) ? (256 - sfirst + sstride - 1) / sstride : 0;
    for (int ui = 0; ui < nprompt_it + nsample_it; ++ui) {
        const int wu = (ui < nprompt_it) ? gw + ui * NGW : 4096 + sfirst + (ui - nprompt_it) * sstride;
        int h, qb, P, qrow0, T; const float *Kpast, *Vpast; const bf16_t *Kn, *Vn;
        if (wu < 4096) { const int b = wu >> 11, rem = wu & 2047; h = rem >> 8; qb = rem & 255; P = 0; T = 8192; qrow0 = b * 8192 + 32 * qb;
            Kn = KBF + (size_t)b * 8192 * 512; Vn = VT + (size_t)(b * 8 + h) * 64 * 8192; Kpast = nullptr; Vpast = nullptr; }
        else { const int su = wu - 4096, bs = su >> 4; h = (su >> 1) & 7; qb = su & 1; P = PAST; T = 64; qrow0 = TPROMPT + bs * 64 + 32 * qb;
            Kn = KBF + (size_t)(TPROMPT + bs * 64) * 512; Vn = VT + (size_t)16 * 64 * 8192 + (size_t)(bs * 8 + h) * 64 * 64;
            Kpast = A->in[2] + (size_t)bs * PAST * 512; Vpast = A->in[3] + (size_t)bs * PAST * 512; }
        const int Q0 = P + 32 * qb, qpos = Q0 + r32;
        bf16x8 qr[4];
#pragma unroll
        for (int d0 = 0; d0 < 4; ++d0) qr[d0] = *(const bf16x8*)(QA + (size_t)(qrow0 + r32) * 512 + h * 64 + d0 * 16 + hi * 8);
        f32x16 o0, o1;
#pragma unroll
        for (int r = 0; r < 16; ++r) { o0[r] = 0.f; o1[r] = 0.f; }
        float carry = 0.f;
        for (int kt = Q0 >> 6; kt >= 0; --kt) {
            const int kb = kt * 64;
            bf16x8 kf[8], vf[8];
            if (kb >= P) {
                const bf16_t* kp = Kn + (size_t)(kb - P + r32) * 512 + h * 64 + hi * 8;
#pragma unroll
                for (int d0 = 0; d0 < 4; ++d0) { kf[2 * d0] = *(const bf16x8*)(kp + d0 * 16); kf[2 * d0 + 1] = *(const bf16x8*)(kp + 32 * 512 + d0 * 16); }
                const bf16_t* vp = Vn + (size_t)r32 * T + (kb - P) + 8 * hi;
#pragma unroll
                for (int jj = 0; jj < 4; ++jj) { vf[2 * jj] = *(const bf16x8*)(vp + 16 * jj); vf[2 * jj + 1] = *(const bf16x8*)(vp + (size_t)32 * T + 16 * jj); }
            } else {
                const float* Kt = Kpast + (size_t)kb * 512; const float* Vt = Vpast + (size_t)kb * 512;
#pragma unroll
                for (int d0 = 0; d0 < 4; ++d0) { const float* k0 = Kt + (size_t)r32 * 512 + h * 64 + d0 * 16 + hi * 8; const float* k1 = k0 + 32 * 512;
                    kf[2 * d0] = cvt8(*(const f32x4*)k0, *(const f32x4*)(k0 + 4)); kf[2 * d0 + 1] = cvt8(*(const f32x4*)k1, *(const f32x4*)(k1 + 4)); }
#pragma unroll
                for (int jj = 0; jj < 4; ++jj) { const float* vb = Vt + (size_t)(32 * (jj >> 1) + 16 * (jj & 1) + 4 * hi) * 512 + h * 64 + r32;
#pragma unroll
                    for (int dd = 0; dd < 2; ++dd) { const float* v = vb + 32 * dd;
                        u32x4 vw; vw.x = pk2(v[0], v[512]); vw.y = pk2(v[1024], v[1536]); vw.z = pk2(v[8 * 512], v[9 * 512]); vw.w = pk2(v[10 * 512], v[11 * 512]);
                        vf[2 * jj + dd] = __builtin_bit_cast(bf16x8, vw); } }
            }
            f32x16 p0, p1;
#pragma unroll
            for (int r = 0; r < 16; ++r) { p0[r] = 0.f; p1[r] = 0.f; }
#pragma unroll
            for (int d0 = 0; d0 < 4; ++d0) {
                p0 = __builtin_amdgcn_mfma_f32_32x32x16_bf16(kf[2 * d0], qr[d0], p0, 0, 0, 0);
                p1 = __builtin_amdgcn_mfma_f32_32x32x16_bf16(kf[2 * d0 + 1], qr[d0], p1, 0, 0, 0);
            }
            f32x16 s0, s1; float G[8];
#pragma unroll
            for (int g = 0; g < 4; ++g) {
                float run0 = 0.f, run1 = 0.f;
#pragma unroll
                for (int e = 3; e >= 0; --e) { const int r = 4 * g + e; const int key = kb + crow(r, hi);
                    const float z0 = p0[r], z1 = p1[r];
                    const float l0 = (key < qpos) ? -(fmaxf(z0, 0.f) + __builtin_amdgcn_logf(1.f + __builtin_amdgcn_exp2f(-fabsf(z0)))) : 0.f;
                    const float l1 = (key + 32 < qpos) ? -(fmaxf(z1, 0.f) + __builtin_amdgcn_logf(1.f + __builtin_amdgcn_exp2f(-fabsf(z1)))) : 0.f;
                    run0 += l0; run1 += l1; s0[r] = run0; s1[r] = run1; }
                G[g] = run0; G[4 + g] = run1;
            }
            float Gx[8], R[8];
#pragma unroll
            for (int g = 0; g < 8; ++g) Gx[g] = __shfl_xor(G[g], 32);
            float run = 0.f;
#pragma unroll
            for (int g = 7; g >= 0; --g) { R[g] = run; run += G[g] + Gx[g]; }
#pragma unroll
            for (int g = 0; g < 4; ++g) {
                const float off0 = carry + R[g] + (hi == 0 ? Gx[g] : 0.f), off1 = carry + R[4 + g] + (hi == 0 ? Gx[4 + g] : 0.f);
#pragma unroll
                for (int e = 0; e < 4; ++e) { const int r = 4 * g + e; const int key = kb + crow(r, hi);
                    p0[r] = (key < qpos) ? __builtin_amdgcn_exp2f(p0[r] + s0[r] + off0) : 0.f;
                    p1[r] = (key + 32 < qpos) ? __builtin_amdgcn_exp2f(p1[r] + s1[r] + off1) : 0.f; }
            }
            carry += run;
#pragma unroll
            for (int jj = 0; jj < 4; ++jj) {
                u32x4 pw;
                if (jj < 2) { const int b = 8 * jj; pw.x = pk2(p0[b], p0[b + 1]); pw.y = pk2(p0[b + 2], p0[b + 3]); pw.z = pk2(p0[b + 4], p0[b + 5]); pw.w = pk2(p0[b + 6], p0[b + 7]); }
                else { const int b = 8 * (jj - 2); pw.x = pk2(p1[b], p1[b + 1]); pw.y = pk2(p1[b + 2], p1[b + 3]); pw.z = pk2(p1[b + 4], p1[b + 5]); pw.w = pk2(p1[b + 6], p1[b + 7]); }
                const bf16x8 pa = __builtin_bit_cast(bf16x8, pw);
                o0 = __builtin_amdgcn_mfma_f32_32x32x16_bf16(pa, vf[2 * jj], o0, 0, 0, 0);
                o1 = __builtin_amdgcn_mfma_f32_32x32x16_bf16(pa, vf[2 * jj + 1], o1, 0, 0, 0);
            }
            if (__all(carry < -86.56f)) break;
        }
        bf16_t* ob = OC + (size_t)qrow0 * DM + h * 64 + r32;
#pragma unroll
        for (int r = 0; r < 16; ++r) { const int q = crow(r, hi); ob[(size_t)q * DM] = (bf16_t)(pk2(o0[r], 0.f) & 0xffffu); ob[(size_t)q * DM + 32] = (bf16_t)(pk2(o1[r], 0.f) & 0xffffu); }
    }
}

__device__ __forceinline__ void hg_item(int it, int& tok0, int& h) { if (it < 1024) { const int b = it >> 9, n = (it >> 2) & 127; h = it & 3; tok0 = b * 8192 + n * 64; } else { const int s = it - 1024; h = s & 3; tok0 = TPROMPT + (s >> 2) * 64; } }
constexpr int HP = 72;
__device__ __forceinline__ unsigned off_b(unsigned row, unsigned ch) { return 256u * row + 16u * (ch ^ (((row & 3) << 2) | ((row >> 2) & 3))); }
__device__ __forceinline__ unsigned tr_addr16(unsigned lane, unsigned c, unsigned ks, unsigned t) { const unsigned g = lane >> 4, q = (lane & 15) >> 2, p = lane & 3; return off_b(32 * ks + 8 * g + 4 * t + q, 2 * c + (p >> 1)) + 8 * (p & 1); }
typedef unsigned short u16x4_t __attribute__((ext_vector_type(4)));
__device__ __forceinline__ bf16x8 tr_frag16(unsigned base, unsigned lane, unsigned c, unsigned ks) {
    u16x4_t r0, r1; const unsigned a0 = base + tr_addr16(lane, c, ks, 0), a1 = base + tr_addr16(lane, c, ks, 1);
    asm volatile("ds_read_b64_tr_b16 %0, %2\n\tds_read_b64_tr_b16 %1, %3\n\ts_waitcnt lgkmcnt(0)" : "=&v"(r0), "=&v"(r1) : "v"(a0), "v"(a1) : "memory");
    return (bf16x8){(short)r0[0], (short)r0[1], (short)r0[2], (short)r0[3], (short)r1[0], (short)r1[1], (short)r1[2], (short)r1[3]};
}
constexpr int RP = 136;
#define HG_PREFETCH(it_) do { int tokP, hP; hg_item((it_), tokP, hP); \
        _Pragma("unroll") for (int i = 0; i < 4; ++i) { const int idx = tid + 512 * i, t = idx >> 5, c4 = idx & 31; lfv[i] = *(const f32x4*)(LF + (size_t)(tokP + t) * 512 + hP * 128 + 4 * c4); } \
        _Pragma("unroll") for (int i = 0; i < 2; ++i) { const int idx = tid + 512 * i, t = idx >> 4, c8 = idx & 15; const size_t o = (size_t)(tokP + t) * 512 + hP * 128 + 8 * c8; \
            ibv[i] = *(const u32x4*)(IB + o); kbv[i] = *(const u32x4*)(KB + o); qbv[i] = *(const u32x4*)(QB + o); } } while (0)
__device__ __forceinline__ void hgrn_a_phase(KA A, LAS unsigned char* lds, int tid, int lane, int wave) {
    unsigned char* ws = A->ws;
    const bf16_t* QB = (const bf16_t*)(ws + WS_QB); const bf16_t* KB = (const bf16_t*)(ws + WS_KB); const bf16_t* IB = (const bf16_t*)(ws + WS_IB);
    const float* LF = (const float*)(ws + WS_LF);
    bf16_t* QT = (bf16_t*)(ws + WS_QT); float* OI = (float*)(ws + WS_OI); float* UT = (float*)(ws + WS_UT); float* DEC = (float*)(ws + WS_DEC);
    LAS float* Lb = (LAS float*)lds;
    LAS unsigned char* Vr = lds + 32768;
    LAS unsigned char* KUr = lds + 51200;
    LAS bf16_t* Pm = (LAS bf16_t*)(lds + 69632);
    LAS bf16_t* Qr = (LAS bf16_t*)(lds + 78848);
    LAS bf16_t* Kr = (LAS bf16_t*)(lds + 96256);
    LAS float* SEGB = (LAS float*)(lds + 113664);
    const int fr = lane & 15, fq = lane >> 4, cc = tid & 127, tq = wave >> 1;
    f32x4 lfv[4]; u32x4 ibv[2], kbv[2], qbv[2];
    int it = blockIdx.x;
    if (it < 1088) HG_PREFETCH(it);
    for (; it < 1088; it += gridDim.x) {
        int tok0, h; hg_item(it, tok0, h);
        f32x4 lfc[4]; u32x4 ibc[2], kbc[2], qbc[2];
#pragma unroll
        for (int i = 0; i < 4; ++i) lfc[i] = lfv[i];
#pragma unroll
        for (int i = 0; i < 2; ++i) { ibc[i] = ibv[i]; kbc[i] = kbv[i]; qbc[i] = qbv[i]; }
        asm volatile("" ::: "memory");
        if (it + (int)gridDim.x < 1088) HG_PREFETCH(it + (int)gridDim.x);
        asm volatile("" ::: "memory");
        LBAR();
#pragma unroll
        for (int i = 0; i < 4; ++i) { const int idx = tid + 512 * i, t = idx >> 5, c4 = idx & 31; *(LAS f32x4*)(Lb + t * 128 + 4 * c4) = lfc[i]; }
#pragma unroll
        for (int i = 0; i < 2; ++i) { const int idx = tid + 512 * i, t = idx >> 4, v8 = idx & 15;
            *(LAS u32x4*)(Vr + off_b(t, v8)) = ibc[i];
            *(LAS u32x4*)(Qr + t * RP + 8 * v8) = qbc[i]; *(LAS u32x4*)(Kr + t * RP + 8 * v8) = kbc[i]; }
        for (int i = tid; i < 64 * HP * 2 / 16; i += NTHREADS) *(LAS u32x4*)((LAS unsigned char*)Pm + 16 * i) = (u32x4){0u, 0u, 0u, 0u};
        LBAR();
        { float run = 0.f;
#pragma unroll
            for (int i = 0; i < 16; ++i) { const int t = 16 * tq + i; run += Lb[t * 128 + cc]; Lb[t * 128 + cc] = run; }
            SEGB[tq * 128 + cc] = run; }
        LBAR();
        if (tq > 0) { float off = 0.f;
#pragma unroll
            for (int sgm = 0; sgm < 3; ++sgm) if (sgm < tq) off += SEGB[sgm * 128 + cc];
#pragma unroll
            for (int i = 0; i < 16; ++i) { const int t = 16 * tq + i; Lb[t * 128 + cc] += off; } }
        LBAR();
#pragma unroll
        for (int i = 0; i < 2; ++i) { const int idx = tid + 512 * i, t = idx >> 4, c8 = idx & 15;
            const u32x4 kw = kbc[i], qw = qbc[i];
            float kf[8] = {bflo(kw.x), bfhi(kw.x), bflo(kw.y), bfhi(kw.y), bflo(kw.z), bfhi(kw.z), bflo(kw.w), bfhi(kw.w)};
            float qf[8] = {bflo(qw.x), bfhi(qw.x), bflo(qw.y), bfhi(qw.y), bflo(qw.z), bfhi(qw.z), bflo(qw.w), bfhi(qw.w)};
            float qo[8];
            float ku[8];
#pragma unroll
            for (int e = 0; e < 8; ++e) { const float bt = Lb[t * 128 + 8 * c8 + e], bl = Lb[63 * 128 + 8 * c8 + e];
                ku[e] = kf[e] * __expf(bl - bt); qo[e] = qf[e] * __expf(bt); }
            { u32x4 kv; kv.x = pk2(ku[0], ku[1]); kv.y = pk2(ku[2], ku[3]); kv.z = pk2(ku[4], ku[5]); kv.w = pk2(ku[6], ku[7]); *(LAS u32x4*)(KUr + off_b(t, c8)) = kv; }
            u32x4 qv; qv.x = pk2(qo[0], qo[1]); qv.y = pk2(qo[2], qo[3]); qv.z = pk2(qo[4], qo[5]); qv.w = pk2(qo[6], qo[7]);
            *(u32x4*)(QT + (size_t)(tok0 + t) * 512 + h * 128 + 8 * c8) = qv; }
        if (tid < 128) DEC[(size_t)it * 128 + tid] = __expf(Lb[63 * 128 + tid]);
        for (int bi = wave; bi < 10; bi += 8) {
            const int I = bi < 1 ? 0 : bi < 3 ? 1 : bi < 6 ? 2 : 3, J = bi - (I * (I + 1)) / 2;
            const int sI = 16 * J + fr, t = 16 * I + fr;
            f32x4 acc = {0.f, 0.f, 0.f, 0.f};
#pragma unroll
            for (int kk = 0; kk < 4; ++kk) {
                const int c0 = 32 * kk + 8 * fq;
                const u32x4 kw = *(const LAS u32x4*)(Kr + sI * RP + c0);
                const u32x4 qw = *(const LAS u32x4*)(Qr + t * RP + c0);
                float kf[8] = {bflo(kw.x), bfhi(kw.x), bflo(kw.y), bfhi(kw.y), bflo(kw.z), bfhi(kw.z), bflo(kw.w), bfhi(kw.w)};
                float qf[8] = {bflo(qw.x), bfhi(qw.x), bflo(qw.y), bfhi(qw.y), bflo(qw.z), bfhi(qw.z), bflo(qw.w), bfhi(qw.w)};
#pragma unroll
                for (int e = 0; e < 8; ++e) { const float BI = (I > 0) ? Lb[(16 * I - 1) * 128 + c0 + e] : 0.f;
                    kf[e] *= __expf(BI - Lb[sI * 128 + c0 + e]); qf[e] *= __expf(Lb[t * 128 + c0 + e] - BI); }
                u32x4 ka, qa; ka.x = pk2(kf[0], kf[1]); ka.y = pk2(kf[2], kf[3]); ka.z = pk2(kf[4], kf[5]); ka.w = pk2(kf[6], kf[7]);
                qa.x = pk2(qf[0], qf[1]); qa.y = pk2(qf[2], qf[3]); qa.z = pk2(qf[4], qf[5]); qa.w = pk2(qf[6], qf[7]);
                acc = __builtin_amdgcn_mfma_f32_16x16x32_bf16(__builtin_bit_cast(bf16x8, ka), __builtin_bit_cast(bf16x8, qa), acc, 0, 0, 0);
            }
            if (I == J) {
#pragma unroll
                for (int j = 0; j < 4; ++j) if (4 * fq + j > fr) acc[j] = 0.f; }
            u32x2 w; w.x = pk2(acc[0], acc[1]); w.y = pk2(acc[2], acc[3]);
            *(LAS u32x2*)(Pm + t * HP + 16 * J + 4 * fq) = w;
        }
        LBAR();
        {
            bf16x8 va[2];
#pragma unroll
            for (int ks = 0; ks < 2; ++ks) va[ks] = tr_frag16((unsigned)(size_t)Vr, (unsigned)lane, (unsigned)wave, (unsigned)ks);
#pragma unroll
            for (int ni = 0; ni < 4; ++ni) { f32x4 acc = {0.f, 0.f, 0.f, 0.f};
#pragma unroll
                for (int ks = 0; ks < 2; ++ks) { const bf16x8 pb = *(const LAS bf16x8*)(Pm + (16 * ni + fr) * HP + 32 * ks + 8 * fq); acc = __builtin_amdgcn_mfma_f32_16x16x32_bf16(va[ks], pb, acc, 0, 0, 0); }
                *(f32x4*)(OI + (size_t)(tok0 + 16 * ni + fr) * 512 + h * 128 + 16 * wave + 4 * fq) = acc; }
#pragma unroll
            for (int ni = 0; ni < 8; ++ni) { f32x4 acc = {0.f, 0.f, 0.f, 0.f};
#pragma unroll
                for (int ks = 0; ks < 2; ++ks) { const bf16x8 kb2 = tr_frag16((unsigned)(size_t)KUr, (unsigned)lane, (unsigned)ni, (unsigned)ks);
                    acc = (it < 1024) ? __builtin_amdgcn_mfma_f32_16x16x32_bf16(kb2, va[ks], acc, 0, 0, 0)
                                      : __builtin_amdgcn_mfma_f32_16x16x32_bf16(va[ks], kb2, acc, 0, 0, 0); }
                if (it < 1024) *(f32x4*)(UT + ((size_t)it * 128 + 16 * wave + fr) * 128 + 16 * ni + 4 * fq) = acc;
                else *(f32x4*)(UT + ((size_t)it * 128 + 16 * ni + fr) * 128 + 16 * wave + 4 * fq) = acc;
                }
        }
    }
    __syncthreads();
}
__device__ __forceinline__ void hgrn_b_phase(KA A, LAS unsigned char* lds, int tid) {
    unsigned char* ws = A->ws;
    const float* __restrict__ UT = (const float*)(ws + WS_UT); const float* __restrict__ DEC = (const float*)(ws + WS_DEC); bf16_t* __restrict__ SNT = (bf16_t*)(ws + WS_SNT);
    LAS float* T = (LAS float*)lds;
    for (int q = (int)blockIdx.x; q < 256; q += gridDim.x) {
        const int s0i = q >> 2, c0 = 32 * (q & 3);
        const size_t it = 1024 + s0i; const float* S0 = A->in[4] + (size_t)s0i * 16384 + c0 * 128; float* So = A->out + O_SS + (size_t)s0i * 16384 + c0 * 128;
        __syncthreads();
#pragma unroll
        for (int i = 0; i < 8; ++i) { const int e = tid + 512 * i, cl = e >> 7, v = e & 127; const float x = S0[e];
            T[cl * 129 + v] = x; So[e] = DEC[it * 128 + c0 + cl] * x + UT[it * 16384 + c0 * 128 + e]; }
        __syncthreads();
#pragma unroll
        for (int i = 0; i < 8; ++i) { const int e = tid + 512 * i, v = e >> 5, cl = e & 31; SNT[it * 16384 + v * 128 + c0 + cl] = (bf16_t)(pk2(T[cl * 129 + v], 0.f) & 0xffffu); }
    }
    const size_t gt = (size_t)blockIdx.x * NTHREADS + tid, GT = (size_t)gridDim.x * NTHREADS;
    for (size_t e = gt; e < 131072; e += GT) {
        const int bh = (int)(e >> 14), vc = (int)(e & 16383), v = vc >> 7, c = vc & 127, b = bh >> 2, h = bh & 3;
        float S = 0.f;
#pragma unroll 32
        for (int n = 0; n < 128; ++n) { const size_t it = (size_t)b * 512 + n * 4 + h;
            SNT[it * 16384 + vc] = (bf16_t)(pk2(S, 0.f) & 0xffffu);
            S = DEC[it * 128 + c] * S + UT[it * 16384 + vc]; }
        A->out[O_SP + ((size_t)(b * 4 + h) * 128 + c) * 128 + v] = S;
    }
}
__device__ __forceinline__ void hgrn_c_phase(KA A, int lane, int wave) {
    unsigned char* ws = A->ws;
    const bf16_t* SNT = (const bf16_t*)(ws + WS_SNT); const bf16_t* QT = (const bf16_t*)(ws + WS_QT); const float* OI = (const float*)(ws + WS_OI);
    const bf16_t* GB = (const bf16_t*)(ws + WS_GB); bf16_t* OC = (bf16_t*)(ws + WS_ABUF); const float* gn = A->in[15];
    const int gw = blockIdx.x * NWAVES + wave, NGW = gridDim.x * NWAVES, fr = lane & 15, fq = lane >> 4;
    for (int wi = gw; wi < 4352; wi += NGW) {
        const int it = wi >> 2, mt = wi & 3; int tok0, h; hg_item(it, tok0, h);
        const int tok = tok0 + 16 * mt + fr;
        f32x4 acc[8];
#pragma unroll
        for (int mi = 0; mi < 8; ++mi) acc[mi] = (f32x4){0.f, 0.f, 0.f, 0.f};
#pragma unroll
        for (int kk = 0; kk < 4; ++kk) {
            const bf16x8 qb = *(const bf16x8*)(QT + (size_t)tok * 512 + h * 128 + 32 * kk + 8 * fq);
#pragma unroll
            for (int mi = 0; mi < 8; ++mi) { const bf16x8 sa = *(const bf16x8*)(SNT + (size_t)it * 16384 + (32 * (mi >> 1) + 8 * (fr >> 2) + 4 * (mi & 1) + (fr & 3)) * 128 + 32 * kk + 8 * fq);
                acc[mi] = __builtin_amdgcn_mfma_f32_16x16x32_bf16(sa, qb, acc[mi], 0, 0, 0); }
        }
        float ss = 0.f;
#pragma unroll
        for (int mi = 0; mi < 8; ++mi) { acc[mi] = acc[mi] + *(const f32x4*)(OI + (size_t)tok * 512 + h * 128 + 32 * (mi >> 1) + 8 * fq + 4 * (mi & 1));
            ss += (acc[mi].x * acc[mi].x + acc[mi].y * acc[mi].y) + (acc[mi].z * acc[mi].z + acc[mi].w * acc[mi].w); }
        ss += __shfl_xor(ss, 16); ss += __shfl_xor(ss, 32);
        const float rstd = rsqrtf(ss * (1.f / 128.f) + EPSV);
#pragma unroll
        for (int mp = 0; mp < 4; ++mp) { const int vcol = h * 128 + 32 * mp + 8 * fq;
            const f32x4 g0 = *(const f32x4*)(gn + vcol), g1 = *(const f32x4*)(gn + vcol + 4); const u32x4 gw4 = *(const u32x4*)(GB + (size_t)tok * 512 + vcol);
            const f32x4 y0 = acc[2 * mp] * rstd * g0, y1 = acc[2 * mp + 1] * rstd * g1;
            u32x4 w; w.x = pk2(y0.x * bflo(gw4.x), y0.y * bfhi(gw4.x)); w.y = pk2(y0.z * bflo(gw4.y), y0.w * bfhi(gw4.y));
            w.z = pk2(y1.x * bflo(gw4.z), y1.y * bfhi(gw4.z)); w.w = pk2(y1.z * bflo(gw4.w), y1.w * bfhi(gw4.w));
            *(u32x4*)(OC + (size_t)tok * DM + 512 + vcol) = w; }
    }
}

constexpr int LP = 129;
__device__ __forceinline__ float neg_expm1(float x) {
    const float p = -x * (1.f + x * (0.5f + x * (0.16666667f + x * (0.041666668f + x * (0.008333334f + x * 0.0013888889f)))));
    return x > -0.25f ? p : 1.f - __expf(x);
}
#define LRU_DECODE(li_, tile_, blk_, prompt_, b_, n_, bs_, srow0_, tloc0_) \
    const int tile_ = (li_) >> 3, blk_ = (li_) & 7; const bool prompt_ = tile_ < 256; const int b_ = tile_ >> 7, n_ = tile_ & 127, bs_ = tile_ - 256; \
    const int srow0_ = prompt_ ? b_ * 8192 : TPROMPT + bs_ * 64; const int tloc0_ = prompt_ ? n_ * 64 : 0;
#define LRU_PREFETCH(li_) do { LRU_DECODE(li_, tileP, blkP, promptP, bP, nP, bsP, srow0P, tloc0P) \
        const int chP = blkP * 128 + c; const int p0P = tloc0P + 16 * tq; \
        const float* cpast = A->in[5]; \
        _Pragma("unroll") for (int hh = 0; hh < 3; ++hh) { const int pp = p0P - 3 + hh; \
            const float* src = (pp >= 0) ? XBR + (size_t)(srow0P + pp) * DM + chP : (promptP ? XBR + chP : cpast + (size_t)(bsP * 3 + 3 + pp) * 1024 + chP); \
            const float vv = *src; xh[hh] = (pp < 0 && promptP) ? 0.f : vv; } \
        _Pragma("unroll") for (int i = 0; i < 16; ++i) xn[i] = XBR[(size_t)(srow0P + p0P + i) * DM + chP]; } while (0)
template <bool UNUSED_>
__device__ __forceinline__ void lru_phase(KA A, LAS unsigned char* lds, int tid, int lane, int wave) {
    unsigned char* ws = A->ws;
    const float* XBR = (const float*)(ws + WS_XBR); const bf16_t* GG = (const bf16_t*)(ws + WS_GG); bf16_t* YIN = (bf16_t*)(ws + WS_ABUF);
    float* AGGA = (float*)(ws + WS_AGGA); float* AGGH = (float*)(ws + WS_AGGH); bf16_t* LAB = (bf16_t*)(ws + WS_LAB); bf16_t* UUB = (bf16_t*)(ws + WS_UUB);
    const bf16_t* WLA = (const bf16_t*)(ws + WS_WLRU); const bf16_t* WLX = WLA + 8 * 16384;
    LAS bf16_t* XCb = (LAS bf16_t*)lds;
    LAS float* XCf = (LAS float*)(lds + 17408);
    LAS float* Af = (LAS float*)(lds + 17408 + 33024);
    LAS float* Uf = (LAS float*)(lds + 17408 + 2 * 33024);
    LAS float* SEG = (LAS float*)(lds + 17408 + 3 * 33024);
    LAS float* SEG2 = SEG + 1024;
    const int fr = lane & 15, fq = lane >> 4, c = tid & 127, tq = wave >> 1;
    float xn[16], xh[3];
    int li = blockIdx.x;
    if (li < 2176) LRU_PREFETCH(li);
    for (; li < 2176; li += gridDim.x) {
        LRU_DECODE(li, tile, blk, prompt, b, n, bs, srow0, tloc0)
        const int ch0 = blk * 128, ch = ch0 + c, tok0 = srow0 + tloc0;
        const bool FIN = !prompt;
        const float cw0 = A->in[18][ch], cw1 = A->in[18][1024 + ch], cw2 = A->in[18][2048 + ch], cw3 = A->in[18][3072 + ch], cb = A->in[19][ch];
        bf16x8 wa[4], wx[4];
#pragma unroll
        for (int kk = 0; kk < 4; ++kk) { wa[kk] = *(const bf16x8*)(WLA + (size_t)blk * 16384 + (16 * wave + fr) * 128 + 32 * kk + 8 * fq);
                                         wx[kk] = *(const bf16x8*)(WLX + (size_t)blk * 16384 + (16 * wave + fr) * 128 + 32 * kk + 8 * fq); }
        float ba4[4], bx4[4], lam4[4];
#pragma unroll
        for (int j = 0; j < 4; ++j) { const int cj = ch0 + 16 * wave + 4 * fq + j; ba4[j] = A->in[21][cj]; bx4[j] = A->in[23][cj]; lam4[j] = A->in[24][cj]; }
        u32x4 gwv[2];
        if (FIN) {
#pragma unroll
            for (int i = 0; i < 2; ++i) { const int idx = tid + 512 * i, t = idx >> 4, c8 = idx & 15; gwv[i] = *(const u32x4*)(GG + (size_t)(tok0 + t) * DM + ch0 + 8 * c8); }
        }
        asm volatile("" ::: "memory");
        float xv[16], xm3 = xh[0], xm2 = xh[1], xm1 = xh[2];
#pragma unroll
        for (int i = 0; i < 16; ++i) xv[i] = xn[i];
        if (li + (int)gridDim.x < 2176) LRU_PREFETCH(li + (int)gridDim.x);
        asm volatile("" ::: "memory");
        LBAR();
#pragma unroll
        for (int i = 0; i < 16; ++i) { const int t = 16 * tq + i; const float x0 = xv[i];
            const float xc = cb + cw0 * xm3 + cw1 * xm2 + cw2 * xm1 + cw3 * x0;
            XCf[t * LP + c] = xc; XCb[t * 136 + c] = (bf16_t)(pk2(xc, 0.f) & 0xffffu);
            xm3 = xm2; xm2 = xm1; xm1 = x0; }
        LBAR();
        {
            f32x4 accA[4], accX[4];
#pragma unroll
            for (int ni = 0; ni < 4; ++ni) { accA[ni] = (f32x4){0.f, 0.f, 0.f, 0.f}; accX[ni] = (f32x4){0.f, 0.f, 0.f, 0.f}; }
#pragma unroll
            for (int kk = 0; kk < 4; ++kk) {
#pragma unroll
                for (int ni = 0; ni < 4; ++ni) { const bf16x8 xb = *(const LAS bf16x8*)(XCb + (16 * ni + fr) * 136 + 32 * kk + 8 * fq);
                    accA[ni] = __builtin_amdgcn_mfma_f32_16x16x32_bf16(wa[kk], xb, accA[ni], 0, 0, 0);
                    accX[ni] = __builtin_amdgcn_mfma_f32_16x16x32_bf16(wx[kk], xb, accX[ni], 0, 0, 0); }
            }
            float L8[4];
#pragma unroll
            for (int j = 0; j < 4; ++j) { const float e = __expf(-lam4[j]); L8[j] = -8.f * (e < 0.01f ? e * (1.f - e * (0.5f - e * 0.33333334f)) : __logf(1.f + e)); }
#pragma unroll
            for (int ni = 0; ni < 4; ++ni) { const int t = 16 * ni + fr;
#pragma unroll
                for (int j = 0; j < 4; ++j) { const int cl = 16 * wave + 4 * fq + j;
                    const float r = sigm(accA[ni][j] + ba4[j]), gi = sigm(accX[ni][j] + bx4[j]);
                    const float la = r * L8[j], a = __expf(la);
                    float mult = __builtin_amdgcn_sqrtf(neg_expm1(2.f * la));
                    if (prompt && n == 0 && t == 0) mult = 1.f;
                    const float xcv = XCf[t * LP + cl]; Af[t * LP + cl] = a; Uf[t * LP + cl] = mult * gi * xcv; if (!FIN) XCf[t * LP + cl] = la; }
            }
        }
        LBAR();
        {
            float Ac = 1.f, hl = 0.f;
#pragma unroll
            for (int i = 0; i < 16; ++i) { const int t = 16 * tq + i; const float a = Af[t * LP + c]; hl = a * hl + Uf[t * LP + c]; Ac *= a; }
            SEG[(tq * 128 + c) * 2] = Ac; SEG[(tq * 128 + c) * 2 + 1] = hl;
        }
        LBAR();
        if (!FIN) {
#pragma unroll
            for (int i = 0; i < 2; ++i) { const int idx = tid + 512 * i, t = idx >> 4, c8 = idx & 15;
                const LAS float* lp = XCf + t * LP + 8 * c8; const LAS float* up = Uf + t * LP + 8 * c8;
                u32x4 w1, w2; w1.x = pk2(lp[0], lp[1]); w1.y = pk2(lp[2], lp[3]); w1.z = pk2(lp[4], lp[5]); w1.w = pk2(lp[6], lp[7]);
                w2.x = pk2(up[0], up[1]); w2.y = pk2(up[2], up[3]); w2.z = pk2(up[4], up[5]); w2.w = pk2(up[6], up[7]);
                *(u32x4*)(LAB + (size_t)(tok0 + t) * DM + ch0 + 8 * c8) = w1; *(u32x4*)(UUB + (size_t)(tok0 + t) * DM + ch0 + 8 * c8) = w2; }
            { const bool last_tile = prompt ? (n == 127) : true;
              if (last_tile && tid < 384) { const int j = tid >> 7; const int T = prompt ? 8192 : 64;
                const float xo = XBR[(size_t)(srow0 + T - 3 + j) * DM + ch];
                if (prompt) A->out[O_CP + (size_t)(b * 3 + j) * 1024 + ch] = xo; else A->out[O_CS + (size_t)(bs * 3 + j) * 1024 + ch] = xo; } }
            if (tq == 0) { float Aa = 1.f, H = 0.f;
#pragma unroll
                for (int s = 0; s < 4; ++s) { const float as = SEG[(s * 128 + c) * 2], hs = SEG[(s * 128 + c) * 2 + 1]; H = as * H + hs; Aa *= as; }
                AGGA[(size_t)tile * 1024 + ch] = Aa; AGGH[(size_t)tile * 1024 + ch] = H; }
        } else {
            float hin;
            hin = A->in[6][(size_t)bs * 1024 + ch];
            float hcur = hin;
#pragma unroll
            for (int s = 0; s < 3; ++s) if (s < tq) hcur = SEG[(s * 128 + c) * 2] * hcur + SEG[(s * 128 + c) * 2 + 1];
#pragma unroll
            for (int i = 0; i < 16; ++i) { const int t = 16 * tq + i; hcur = Af[t * LP + c] * hcur + Uf[t * LP + c]; Uf[t * LP + c] = hcur; }
            const bool last_tile = prompt ? (n == 127) : true;
            if (last_tile && tq == 3) { if (prompt) A->out[O_HP + (size_t)b * 1024 + ch] = hcur; else A->out[O_HS + (size_t)bs * 1024 + ch] = hcur; }
            if (last_tile && tid < 384) { const int j = tid >> 7; const int T = prompt ? 8192 : 64;
                const float xo = XBR[(size_t)(srow0 + T - 3 + j) * DM + ch];
                if (prompt) A->out[O_CP + (size_t)(b * 3 + j) * 1024 + ch] = xo; else A->out[O_CS + (size_t)(bs * 3 + j) * 1024 + ch] = xo; }
            LBAR();
#pragma unroll
            for (int i = 0; i < 2; ++i) { const int idx = tid + 512 * i, t = idx >> 4, c8 = idx & 15;
                const u32x4 gw4 = gwv[i];
                const LAS float* hp = Uf + t * LP + 8 * c8;
                u32x4 w; w.x = pk2(bflo(gw4.x) * hp[0], bfhi(gw4.x) * hp[1]); w.y = pk2(bflo(gw4.y) * hp[2], bfhi(gw4.y) * hp[3]);
                w.z = pk2(bflo(gw4.z) * hp[4], bfhi(gw4.z) * hp[5]); w.w = pk2(bflo(gw4.w) * hp[6], bfhi(gw4.w) * hp[7]);
                *(u32x4*)(YIN + (size_t)(tok0 + t) * DM + ch0 + 8 * c8) = w; }
        }
    }
    __syncthreads();
}

__device__ __forceinline__ void lru_final_phase(KA A, int lane, int wave) {
    unsigned char* ws = A->ws;
    const bf16_t* __restrict__ GG = (const bf16_t*)(ws + WS_GG); bf16_t* __restrict__ YIN = (bf16_t*)(ws + WS_ABUF);
    const float* __restrict__ AGGA = (const float*)(ws + WS_AGGA); const float* __restrict__ AGGH = (const float*)(ws + WS_AGGH);
    const bf16_t* __restrict__ LAB = (const bf16_t*)(ws + WS_LAB); const bf16_t* __restrict__ UUB = (const bf16_t*)(ws + WS_UUB);
    const int gw = blockIdx.x * NWAVES + wave, NGW = gridDim.x * NWAVES;
    for (int wi = gw; wi < 256 * 16; wi += NGW) {
        const int tile = wi >> 4, ch = (wi & 15) * 64 + lane;
        const bool prompt = tile < 256; const int b = tile >> 7, n = tile & 127, bs = tile - 256;
        const int tok0 = prompt ? b * 8192 + n * 64 : TPROMPT + bs * 64;
        float h;
        if (prompt) { h = 0.f; const float* pa = AGGA + (size_t)(b * 128) * 1024 + ch; const float* ph = AGGH + (size_t)(b * 128) * 1024 + ch;
#pragma unroll 16
            for (int np = 0; np < n; ++np) h = pa[(size_t)np * 1024] * h + ph[(size_t)np * 1024]; }
        else h = A->in[6][(size_t)bs * 1024 + ch];
        const size_t o0 = (size_t)tok0 * DM + ch;
#pragma unroll
        for (int g = 0; g < 4; ++g) {
            bf16_t lav[16], uv[16], gv[16];
#pragma unroll
            for (int i = 0; i < 16; ++i) { const size_t o = o0 + (size_t)(16 * g + i) * DM; lav[i] = LAB[o]; uv[i] = UUB[o]; gv[i] = GG[o]; }
#pragma unroll
            for (int i = 0; i < 16; ++i) { const float a = __expf(__uint_as_float((unsigned)lav[i] << 16)); h = a * h + __uint_as_float((unsigned)uv[i] << 16);
                YIN[o0 + (size_t)(16 * g + i) * DM] = (bf16_t)(pk2(__uint_as_float((unsigned)gv[i] << 16) * h, 0.f) & 0xffffu); }
        }
        const bool last_tile = prompt ? (n == 127) : true;
        if (last_tile) { if (prompt) A->out[O_HP + (size_t)b * 1024 + ch] = h; else A->out[O_HS + (size_t)bs * 1024 + ch] = h; }
    }
}

#define XB_XCNT(j)  (256  + 64 * (j))
#define XB_XSUB(j)  (1280 + 64 * (j))
#define XB_XGEN(j)  (2304 + 64 * (j))
#define XB_TOP      3328
#define XB_TOPGEN   3392
#define XCD_BAR_WORDS 3456
__device__ __forceinline__ unsigned xb_ld(unsigned* p)              { return __hip_atomic_load(p, __ATOMIC_RELAXED, __HIP_MEMORY_SCOPE_AGENT); }
__device__ __forceinline__ unsigned xb_add(unsigned* p, unsigned v) { return __hip_atomic_fetch_add(p, v, __ATOMIC_RELAXED, __HIP_MEMORY_SCOPE_AGENT); }
__device__ __forceinline__ unsigned xb_xcc_id() { return (unsigned)__builtin_amdgcn_s_getreg((3 << 11) | 20) & 0xFu; }
__device__ __forceinline__ void xb_census(unsigned* bar, unsigned xcc, volatile LAS unsigned* st) {
    const unsigned G = gridDim.x;
    for (;;) {
        unsigned sum = 0u, cnt = 0u, mine = 0u;
        for (unsigned j = 0; j < 16; ++j) { const unsigned c = xb_ld(&bar[XB_XCNT(j)]); sum += c; cnt += (c > 0u) ? 1u : 0u; mine = (j == xcc) ? c : mine; }
        if (sum == G) { st[0] = mine; st[1] = cnt; break; }
        __builtin_amdgcn_s_sleep(1);
    }
}
template <bool FIRST>
__device__ __forceinline__ void xbar(unsigned* bar, const unsigned xcc, volatile LAS unsigned* st) {
    asm volatile("s_waitcnt vmcnt(0)" ::: "memory");
    __syncthreads();
    if (__builtin_amdgcn_readfirstlane(threadIdx.x >> 6) == 0) {
        const bool l0 = (threadIdx.x == 0);
        __builtin_amdgcn_s_waitcnt(0);
        if (FIRST) { if (l0) xb_census(bar, xcc, st); }
        const unsigned nloc = __builtin_amdgcn_readfirstlane(st[0]), nx = __builtin_amdgcn_readfirstlane(st[1]);
        unsigned old = 0u; if (l0) old = xb_add(&bar[XB_XSUB(xcc)], 1u);
        old = __builtin_amdgcn_readfirstlane(old);
        const unsigned gen = old / nloc;
        if (old + 1u == (gen + 1u) * nloc) {
            __builtin_amdgcn_fence(__ATOMIC_RELEASE, "agent");
            asm volatile("s_waitcnt vmcnt(0)" ::: "memory");
            unsigned og = 0u; if (l0) og = xb_add(&bar[XB_TOP], 1u);
            og = __builtin_amdgcn_readfirstlane(og);
            const unsigned tg = og / nx;
            if (og + 1u == (tg + 1u) * nx) { if (l0) xb_add(&bar[XB_TOPGEN], 1u); }
            else { while (__builtin_amdgcn_readfirstlane(xb_ld(&bar[XB_TOPGEN])) == tg) __builtin_amdgcn_s_sleep(1); }
            __builtin_amdgcn_fence(__ATOMIC_ACQUIRE, "agent");
            if (l0) xb_add(&bar[XB_XGEN(xcc)], 1u);
            asm volatile("s_waitcnt vmcnt(0)" ::: "memory");
        } else {
            while (__builtin_amdgcn_readfirstlane(xb_ld(&bar[XB_XGEN(xcc)])) == gen) __builtin_amdgcn_s_sleep(1);
            __builtin_amdgcn_fence(__ATOMIC_ACQUIRE, "agent");
            asm volatile("s_waitcnt vmcnt(0)" ::: "memory");
        }
    }
    __syncthreads();
}

constexpr int NPHASE = 19;
#define REP_P0 1
#define REP_HA 1
#define REP_SB 1
#define REP_HB 1
#define REP_HC 1
#define REP_L1 1
#define REP_L2 1

#ifndef EN_P0
#define EN_P0 1
#endif
#ifndef EN_HA
#define EN_HA 1
#endif
#ifndef EN_SB
#define EN_SB 1
#endif
#ifndef EN_LRU
#define EN_LRU 1
#endif
#ifndef EN_HC
#define EN_HC 1
#endif

__global__ void __launch_bounds__(NTHREADS, 2) mega_fwd(Args Araw) {
    KA A = kargs();
    extern __shared__ __attribute__((aligned(16))) unsigned char lds_raw[];
    LAS unsigned char* lds = (LAS unsigned char*)lds_raw;
    const int tid = threadIdx.x, lane = tid & 63, wave = __builtin_amdgcn_readfirstlane(tid >> 6);
    unsigned char* ws = A->ws;
    const float* MOD = (const float*)(ws + WS_MOD);
    bf16_t* XB = (bf16_t*)(ws + WS_X);
    float* XSF = (float*)(ws + WS_X + 40 * MiB);
    bf16_t* ABUF = (bf16_t*)(ws + WS_ABUF);
    bf16_t* ABUF2 = (bf16_t*)(ws + WS_ABUF2);
    bf16_t* ACT = (bf16_t*)(ws + WS_ACT);
    const int lo = A->ph_lo, hi = A->ph_hi;
    unsigned* bar = (unsigned*)ws;
    volatile LAS unsigned* st = (volatile LAS unsigned*)(lds + RING_BYTES + 64);
    if (tid < 2) st[tid] = 0u;
    __syncthreads();
    if (hi > 1000) cg::this_grid().sync();
    const unsigned xcc = xb_xcc_id();
    if (tid == 0) (void)xb_add(&bar[XB_XCNT(xcc)], 1u);
#define IN(k) (lo <= (k) && (k) < hi)
#define SEAM(k) do { if (IN(k) && IN((k) + 1)) { if ((k) == 0) xbar<true>(bar, xcc, st); else xbar<false>(bar, xcc, st); } } while (0)
#define MODL(layer) (MOD + (size_t)(layer) * NBB * 6144)
#define GEMM_RES(PH, APTR, WPTR, KK, XOP, XOBF, XWP, LAYER, GI, NG, NSC, NSH, HNP, OUTP, FI) if (IN(PH)) { \
        { pg8::Gemm g{APTR, WPTR, TPROMPT, 1024, KK, KK}; pg8::StaticOrder S; S.init(TPROMPT, 1024, gridDim.x, blockIdx.x); \
          EpiResNorm<(FI) == 3, XOBF> E{XOP, XWP, MODL(LAYER) + (GI) * 1024, NG, NSC, NSH, HNP, OUTP, (float*)(ws + WS_SLOTS), (unsigned*)(ws + WS_CNT) + (FI) * 4096}; \
          pg8::gemm_phase<EpiResNorm<(FI) == 3, XOBF>, pg8::StaticOrder, false, true>(lds, g, S, E); } \
        { pg8::Gemm g{APTR, WPTR, MROWS, 1024, 256, KK}; SplitOrder<(KK) / 256> S{(int)gridDim.x, (int)blockIdx.x}; \
          EpiPart E{(float*)(ws + WS_PART)}; \
          pg8::gemm_phase<EpiPart, SplitOrder<(KK) / 256>, false, true>(lds, g, S, E); } } SEAM(PH);
#define GEMM_GU(PH, LAYER) if (IN(PH)) { \
        pg8::Gemm g{ABUF2, (const bf16_t*)(ws + WS_WGU) + (size_t)(LAYER) * 5632 * 1024, MROWS, 5632, 1024, 1024}; pg8::StaticOrder S; S.init(MROWS, 5632, gridDim.x, blockIdx.x); \
        EpiGU E{ACT}; pg8::gemm_phase<EpiGU, pg8::StaticOrder, true, true>(lds, g, S, E); } SEAM(PH);
    if (IN(0)) { for (int rp = 0; rp < REP_P0; ++rp) prologue_phase(kargs(), lds, tid, lane, wave); } SEAM(0);
    if (IN(1)) norm_mod_phase(A->in[0], A->in[1], A->in[9], MODL(0), 0, 1, ABUF, lane, wave, nullptr, 0, nullptr, nullptr, true, blockIdx.x * NWAVES + wave, gridDim.x * NWAVES); SEAM(1);
    if (IN(2)) {
        pg8::Gemm g{ABUF, (const bf16_t*)(ws + WS_WINE), MROWS, 3584, 1024, 1024}; pg8::StaticOrder S; S.init(MROWS, 3584, gridDim.x, blockIdx.x);
        EpiInEven E{A->out, (bf16_t*)(ws + WS_QA), (bf16_t*)(ws + WS_QB), (bf16_t*)(ws + WS_KB), (bf16_t*)(ws + WS_IB), (bf16_t*)(ws + WS_GB), (float*)(ws + WS_LF), (const float*)(ws + WS_LB), (bf16_t*)(ws + WS_KBF), (bf16_t*)(ws + WS_VT)};
        pg8::gemm_phase<EpiInEven, pg8::StaticOrder, true, true>(lds, g, S, E);
        convert_in_slack<1>(kargs(), lds, lane, wave, (MROWS / 256) * (3584 / 256));
    } SEAM(2);
    if (IN(3)) { for (int rp = 0; rp < REP_HA; ++rp) hgrn_a_phase(kargs(), lds, tid, lane, wave); for (int rp = 0; rp < REP_SB; ++rp) sb_attn_phase(kargs(), lane, wave); } SEAM(3);
    if (IN(4)) { for (int rp = 0; rp < REP_HB; ++rp) hgrn_b_phase(kargs(), lds, tid); } SEAM(4);
    if (IN(5)) { for (int rp = 0; rp < REP_HC; ++rp) hgrn_c_phase(kargs(), lane, wave); } SEAM(5);
    GEMM_RES(6, ABUF, (const bf16_t*)(ws + WS_WOUTE), 1024, A->in[0], false, XB, 0, 2, A->in[10], MODL(0) + 4 * 1024, MODL(0) + 3 * 1024, ABUF2, nullptr, 0)
    if (IN(7)) norm_mod_phase(nullptr, A->in[1], A->in[10], MODL(0), 3, 4, ABUF2, lane, wave, (const float*)(ws + WS_PART), 4, MODL(0) + 2 * 1024, XSF, false, (wave < 4) ? (int)blockIdx.x * 4 + wave : TSAMPLE, (int)gridDim.x * 4); SEAM(7);
    if (IN(8)) { pg8::Gemm g{ABUF2, (const bf16_t*)(ws + WS_WGU), MROWS, 5632, 1024, 1024}; pg8::StaticOrder S; S.init(MROWS, 5632, gridDim.x, blockIdx.x);
        EpiGU E{ACT}; pg8::gemm_phase<EpiGU, pg8::StaticOrder, true, true>(lds, g, S, E);
        convert_in_slack<2>(kargs(), lds, lane, wave, (MROWS / 256) * (5632 / 256)); } SEAM(8);
    GEMM_RES(9, ACT, (const bf16_t*)(ws + WS_WD), DFF, XB, true, XB, 0, 5, A->in[9] + 1024, MODL(1) + 1 * 1024, MODL(1) + 0 * 1024, ABUF2, nullptr, 1)
    if (IN(10)) norm_mod_phase(nullptr, XSF, A->in[9] + 1024, MODL(1), 0, 1, ABUF2, lane, wave, (const float*)(ws + WS_PART), 11, MODL(0) + 5 * 1024, XSF, false, (wave < 4) ? (int)blockIdx.x * 4 + wave : TSAMPLE, (int)gridDim.x * 4); SEAM(10);
    if (IN(11)) {
        pg8::Gemm g{ABUF2, (const bf16_t*)(ws + WS_WINO), MROWS, 2048, 1024, 1024}; pg8::StaticOrder S; S.init(MROWS, 2048, gridDim.x, blockIdx.x);
        EpiInOdd E{(bf16_t*)(ws + WS_GG), (float*)(ws + WS_XBR)};
        pg8::gemm_phase<EpiInOdd, pg8::StaticOrder, true, true>(lds, g, S, E);
        convert_in_slack<3>(kargs(), lds, lane, wave, (MROWS / 256) * (2048 / 256));
    } SEAM(11);
    if (IN(12)) { for (int rp = 0; rp < REP_L1; ++rp) lru_phase<false>(kargs(), lds, tid, lane, wave); } SEAM(12);
    if (IN(13)) { for (int rp = 0; rp < REP_L2; ++rp) lru_final_phase(kargs(), lane, wave); } SEAM(13);
    GEMM_RES(14, ABUF, (const bf16_t*)(ws + WS_WOUTO), 1024, XB, true, XB, 1, 2, A->in[10] + 1024, MODL(1) + 4 * 1024, MODL(1) + 3 * 1024, ABUF2, nullptr, 2)
    if (IN(15)) norm_mod_phase(nullptr, XSF, A->in[10] + 1024, MODL(1), 3, 4, ABUF2, lane, wave, (const float*)(ws + WS_PART), 4, MODL(1) + 2 * 1024, XSF, false, (wave < 4) ? (int)blockIdx.x * 4 + wave : TSAMPLE, (int)gridDim.x * 4); SEAM(15);
    GEMM_GU(16, 1)
    GEMM_RES(17, ACT, (const bf16_t*)(ws + WS_WD) + (size_t)1024 * DFF, DFF, XB, true, nullptr, 1, 5, A->in[29], nullptr, nullptr, nullptr, A->out + O_YP, 3)
    if (IN(18)) norm_mod_phase(nullptr, XSF, A->in[29], MODL(1), 0, 0, nullptr, lane, wave, (const float*)(ws + WS_PART), 11, MODL(1) + 5 * 1024, A->out + O_YS, false, (wave < 4) ? (int)blockIdx.x * 4 + wave : TSAMPLE, (int)gridDim.x * 4);
#undef IN
#undef SEAM
}

#ifndef MK_PER_PHASE
#define MK_PER_PHASE 0
#endif
extern "C" void kernel_launch(void* const* d_in, const int* in_sizes, int n_in, void* d_out, int out_size, void* d_ws, size_t ws_size, hipStream_t stream) {
    static int grid = 0;
    if (grid == 0) {
        if (n_in != 30 || out_size != (int)O_END || ws_size < WS_END) { fprintf(stderr, "kernel_launch: unexpected shapes n_in %d out %d ws %zu\n", n_in, out_size, ws_size); grid = -1; return; }
        int dev = 0, cus = 0, per_cu = 0;
        if (hipGetDevice(&dev) != hipSuccess || hipDeviceGetAttribute(&cus, hipDeviceAttributeMultiprocessorCount, dev) != hipSuccess) { grid = -1; return; }
        if (hipFuncSetAttribute((const void*)mega_fwd, hipFuncAttributeMaxDynamicSharedMemorySize, LDS_BYTES) != hipSuccess) { fprintf(stderr, "kernel_launch: hipFuncSetAttribute failed\n"); grid = -1; return; }
        if (hipOccupancyMaxActiveBlocksPerMultiprocessor(&per_cu, (const void*)mega_fwd, NTHREADS, LDS_BYTES) != hipSuccess || per_cu < 1) { fprintf(stderr, "kernel_launch: occupancy query says %d\n", per_cu); per_cu = 1; }
        (void)hipGetLastError();
        grid = cus >= 256 ? 256 : cus;
        if (grid != 256) fprintf(stderr, "kernel_launch: %d CUs: this build expects 256 workgroups (MI355X)\n", cus);
    }
    if (grid < 0) return;
    Args a{};
    for (int i = 0; i < 30; ++i) a.in[i] = (const float*)d_in[i];
    a.out = (float*)d_out; a.ws = (unsigned char*)d_ws;
#if MK_PER_PHASE
    for (int p = 0; p < NPHASE; ++p) { a.ph_lo = p; a.ph_hi = p + 1; hipLaunchKernelGGL(mega_fwd, dim3(grid), dim3(NTHREADS), LDS_BYTES, stream, a); }
#else
    a.ph_lo = 0; a.ph_hi = NPHASE;
    if (hipMemsetAsync(d_ws, 0, 131072, stream) != hipSuccess) { fprintf(stderr, "kernel_launch: memset of the barrier words failed\n"); return; }
    void* args[] = {&a};
    hipError_t e = hipLaunchCooperativeKernel((const void*)mega_fwd, dim3(grid), dim3(NTHREADS), args, LDS_BYTES, stream);
    if (e != hipSuccess) fprintf(stderr, "cooperative launch failed: %s (grid %d)\n", hipGetErrorString(e), grid);
#endif
}
```

```cpp
#include <hip/hip_runtime.h>
#include <hip/hip_cooperative_groups.h>
#include <cstdio>
#include <cstdint>
namespace cg = cooperative_groups;
namespace pg8 {
#define PG8_LAS __attribute__((address_space(3)))
typedef unsigned short bf16_t;
typedef short bf16x8 __attribute__((ext_vector_type(8)));
typedef float f32x4 __attribute__((ext_vector_type(4)));
typedef unsigned u32x4 __attribute__((ext_vector_type(4)));
constexpr int BM = 256, BK = 64, HALF = 128, HTB = HALF * BK * 2  , STAGE_BYTES = 8 * HTB, NXCD = 8, WGM = 8;

__host__ __device__ __forceinline__ int lds_byte(int r, int c) { const int st = (r >> 4) * 2 + (c >> 5), rr = r & 15, cc = c & 31, ob = rr * 64 + cc * 2; return st * 1024 + (ob ^ (((ob >> 9) & 1) << 5)); }
__host__ __device__ __forceinline__ void stage_rc(int b, int& R, int& C) { const int st = b / 1024, sb = b % 1024, swz = sb ^ (((sb >> 9) & 1) << 5); R = (st >> 1) * 16 + swz / 64; C = (st & 1) * 32 + (swz % 64) / 2; }
__host__ __device__ __forceinline__ int perm32(int rho) { const int n = rho >> 4, i = rho & 15; return 8 * (i >> 2) + 4 * n + (i & 3); }

struct Unit { int pm, pn, kofs; };
struct Gemm { const bf16_t* A; const bf16_t* Bt; int M, N, K, ld; };

struct StaticOrder {
    int nM, nN, nwg, G, c;
    __host__ __device__ void init(int M, int N, int G_, int c_) { nM = M / BM; nN = N / BM; nwg = nM * nN; G = G_; c = c_; }
    __host__ __device__ bool next(int i, Unit& u) const {
        const long L = (long)i * G + c; if (L >= nwg) return false;
        int wgid = (int)L; { const int q = nwg / NXCD, r = nwg % NXCD, xcd = wgid % NXCD, off = wgid / NXCD; wgid = (xcd < r ? xcd * (q + 1) : r * (q + 1) + (xcd - r) * q) + off; }
        const int nig = WGM * nN, gid = wgid / nig, fm = gid * WGM, gsz = (nM - fm) < WGM ? (nM - fm) : WGM;
        u.pm = fm + ((wgid % nig) % gsz); u.pn = (wgid % nig) / gsz; u.kofs = 0; return true;
    }
    __device__ __forceinline__ void a_ready(const Unit&) const {}
    __device__ __forceinline__ void done(const Unit&) const {}
};

__device__ __forceinline__ unsigned cvt_pk_bf16(float lo, float hi) { unsigned r; asm volatile("v_cvt_pk_bf16_f32 %0, %1, %2" : "=v"(r) : "v"(lo), "v"(hi)); return r; }
typedef float f32x2 __attribute__((ext_vector_type(2)));
template <class Epi, class Sched, bool ALIGN_EPI = false, bool SP2 = false>
__device__ __forceinline__ void gemm_phase(PG8_LAS unsigned char* lds, const Gemm g, const Sched& S, const Epi& E) {
    const int tid = threadIdx.x, wid = __builtin_amdgcn_readfirstlane(tid >> 6), lane = tid & 63, wr = wid >> 2, wc = wid & 3, fr = lane & 15, fq = lane >> 4;
    const int K = g.ld, nt = g.K / BK;
    unsigned voffA[2], voffB[2];
#pragma unroll
    for (int i = 0; i < 2; ++i) { int R, C; stage_rc(tid * 16 + i * 8192, R, C); const int Rb = Epi::PERM ? ((R & ~31) + perm32(R & 31)) : R;
        voffA[i] = (unsigned)(R * K + C) * 2u; voffB[i] = (unsigned)(Rb * K + C) * 2u; }
    const size_t kstep = (size_t)(BK * 2);
    const size_t hstep = (size_t)HALF * K * 2;
    const size_t tstep = 2 * hstep;
    const unsigned ldsw = (unsigned)wid * 1024u;
    const int aoff = lds_byte(wr * 64 + fr, fq * 8), boff = lds_byte(wc * 32 + fr, fq * 8);
#define PG8_SA(b, h) (((b) * 2 + (h)) * HTB)
#define PG8_SB(b, h) ((4 + (b) * 2 + (h)) * HTB)
#define PG8_STAGE(bufoff, gbase, voff) do { _Pragma("unroll") for (int _i = 0; _i < 2; ++_i) \
        __builtin_amdgcn_global_load_lds((const unsigned*)((const char*)(gbase) + (voff)[_i]), (PG8_LAS unsigned*)(lds + (bufoff) + ldsw + _i * 8192), 16, 0, 0); } while (0)
#define PG8_LDA(dst, b, h) do { _Pragma("unroll") for (int m = 0; m < 4; ++m) _Pragma("unroll") for (int k = 0; k < 2; ++k) dst[m][k] = *(const PG8_LAS bf16x8*)(lds + PG8_SA(b, h) + aoff + m * 2048 + k * 1024); } while (0)
#define PG8_LDB(dst, b, h) do { _Pragma("unroll") for (int n = 0; n < 2; ++n) _Pragma("unroll") for (int k = 0; k < 2; ++k) dst[n][k] = *(const PG8_LAS bf16x8*)(lds + PG8_SB(b, h) + boff + n * 2048 + k * 1024); } while (0)
#define PG8_MMA(ai, bj, At, Bt) do { __builtin_amdgcn_s_setprio(1); _Pragma("unroll") for (int m = 0; m < 4; ++m) _Pragma("unroll") for (int n = 0; n < 2; ++n) _Pragma("unroll") for (int k = 0; k < 2; ++k) \
        acc[ai][bj][m][n] = __builtin_amdgcn_mfma_f32_16x16x32_bf16(Bt[n][k], At[m][k], acc[ai][bj][m][n], 0, 0, 0); __builtin_amdgcn_s_setprio(0); } while (0)
#define PG8_WAIT_V(n) asm volatile("s_waitcnt vmcnt(" #n ")" ::: "memory")
#define PG8_WAIT_L(n) asm volatile("s_waitcnt lgkmcnt(" #n ")" ::: "memory")
#define PG8_BAR __builtin_amdgcn_s_barrier()
#define PG8_SCHED __builtin_amdgcn_sched_barrier(0)
    Unit cur, nxt; int ui = 0;
    if (!S.next(0, cur)) return;
    f32x4 acc[2][2][4][2];
#pragma unroll
    for (int a = 0; a < 2; ++a)
#pragma unroll
        for (int b = 0; b < 2; ++b)
#pragma unroll
            for (int m = 0; m < 4; ++m)
#pragma unroll
                for (int n = 0; n < 2; ++n) acc[a][b][m][n] = (f32x4){0.f, 0.f, 0.f, 0.f};
    bf16x8 At[4][2], B0[2][2], B1[2][2];
    const char* cA = (const char*)g.A + (size_t)cur.pm * tstep + (size_t)cur.kofs * 2; const char* cB = (const char*)g.Bt + (size_t)cur.pn * tstep + (size_t)cur.kofs * 2;
    S.a_ready(cur);
    if constexpr (SP2) {
        PG8_STAGE(PG8_SB(0, 0), cB, voffB); PG8_STAGE(PG8_SB(0, 1), cB + hstep, voffB); PG8_STAGE(PG8_SA(0, 0), cA, voffA); PG8_STAGE(PG8_SA(0, 1), cA + hstep, voffA);
        if (wr == 1) PG8_BAR;
        PG8_WAIT_V(2); PG8_BAR;
        PG8_STAGE(PG8_SB(1, 0), cB + kstep, voffB); PG8_STAGE(PG8_SA(1, 0), cA + kstep, voffA); PG8_STAGE(PG8_SB(1, 1), cB + hstep + kstep, voffB);
        PG8_WAIT_V(6); PG8_BAR;
    } else {
        PG8_STAGE(PG8_SB(0, 0), cB, voffB); PG8_STAGE(PG8_SA(0, 0), cA, voffA); PG8_STAGE(PG8_SB(0, 1), cB + hstep, voffB); PG8_STAGE(PG8_SA(0, 1), cA + hstep, voffA);
        if (wr == 1) PG8_BAR;
        PG8_WAIT_V(4); PG8_BAR;
        PG8_STAGE(PG8_SB(1, 0), cB + kstep, voffB); PG8_STAGE(PG8_SA(1, 0), cA + kstep, voffA); PG8_STAGE(PG8_SB(1, 1), cB + hstep + kstep, voffB);
        PG8_WAIT_V(6); PG8_BAR;
    }
    for (;;) {
        const bool has_next = S.next(ui + 1, nxt);
        const char* nA = has_next ? (const char*)g.A + (size_t)nxt.pm * tstep + (size_t)nxt.kofs * 2 : cA; const char* nB = has_next ? (const char*)g.Bt + (size_t)nxt.pn * tstep + (size_t)nxt.kofs * 2 : cB;
        for (int t = 0; t < nt; t += 2) {
            const bool last = (t == nt - 2);
            const char* a1 = cA + (size_t)(t + 1) * kstep;
            const char* a2 = last ? nA : cA + (size_t)(t + 2) * kstep; const char* b2 = last ? nB : cB + (size_t)(t + 2) * kstep;
            const char* a3 = a2 + kstep; const char* b3 = b2 + kstep;
            if (last && has_next) S.a_ready(nxt);
            if constexpr (SP2) {
            PG8_LDB(B0, 0, 0); PG8_LDB(B1, 0, 1); PG8_SCHED; PG8_LDA(At, 0, 0); PG8_STAGE(PG8_SA(1, 1), a1 + hstep, voffA);
            PG8_WAIT_V(8); PG8_WAIT_L(0); PG8_BAR; PG8_MMA(0, 0, At, B0); PG8_MMA(0, 1, At, B1); PG8_BAR; PG8_SCHED;
            PG8_LDA(At, 0, 1); PG8_STAGE(PG8_SB(0, 0), b2, voffB); PG8_STAGE(PG8_SB(0, 1), b2 + hstep, voffB); PG8_STAGE(PG8_SA(0, 0), a2, voffA);
            PG8_WAIT_V(8); PG8_WAIT_L(0); PG8_BAR; PG8_MMA(1, 0, At, B0); PG8_MMA(1, 1, At, B1); PG8_BAR; PG8_SCHED;
            PG8_LDB(B0, 1, 0); PG8_LDB(B1, 1, 1); PG8_SCHED; PG8_LDA(At, 1, 0); PG8_STAGE(PG8_SA(0, 1), a2 + hstep, voffA);
            PG8_WAIT_V(8); PG8_WAIT_L(0); PG8_BAR; PG8_MMA(0, 0, At, B0); PG8_MMA(0, 1, At, B1); PG8_BAR; PG8_SCHED;
            PG8_LDA(At, 1, 1); PG8_STAGE(PG8_SB(1, 0), b3, voffB); PG8_STAGE(PG8_SB(1, 1), b3 + hstep, voffB); PG8_STAGE(PG8_SA(1, 0), a3, voffA);
            PG8_WAIT_V(8); PG8_WAIT_L(0); PG8_BAR; PG8_MMA(1, 0, At, B0); PG8_MMA(1, 1, At, B1); PG8_BAR; PG8_SCHED;
            } else {
            PG8_LDB(B0, 0, 0); PG8_SCHED; PG8_LDA(At, 0, 0); PG8_STAGE(PG8_SA(1, 1), a1 + hstep, voffA);
            PG8_WAIT_L(8); PG8_BAR; PG8_WAIT_L(0); PG8_MMA(0, 0, At, B0); PG8_BAR; PG8_SCHED;
            PG8_LDB(B1, 0, 1); PG8_STAGE(PG8_SB(0, 0), b2, voffB);
            PG8_BAR; PG8_WAIT_L(0); PG8_MMA(0, 1, At, B1); PG8_BAR;
            PG8_LDA(At, 0, 1); PG8_STAGE(PG8_SA(0, 0), a2, voffA);
            PG8_BAR; PG8_WAIT_L(0); PG8_MMA(1, 0, At, B0); PG8_BAR; PG8_SCHED;
            PG8_STAGE(PG8_SB(0, 1), b2 + hstep, voffB);
            PG8_WAIT_V(6); PG8_BAR; PG8_MMA(1, 1, At, B1); PG8_BAR;
            PG8_LDB(B0, 1, 0); PG8_SCHED; PG8_LDA(At, 1, 0); PG8_STAGE(PG8_SA(0, 1), a2 + hstep, voffA);
            PG8_WAIT_L(8); PG8_BAR; PG8_WAIT_L(0); PG8_MMA(0, 0, At, B0); PG8_BAR; PG8_SCHED;
            PG8_LDB(B1, 1, 1); PG8_STAGE(PG8_SB(1, 0), b3, voffB);
            PG8_BAR; PG8_WAIT_L(0); PG8_MMA(0, 1, At, B1); PG8_BAR;
            PG8_LDA(At, 1, 1); PG8_STAGE(PG8_SA(1, 0), a3, voffA);
            PG8_BAR; PG8_WAIT_L(0); PG8_MMA(1, 0, At, B0); PG8_BAR; PG8_SCHED;
            PG8_STAGE(PG8_SB(1, 1), b3 + hstep, voffB);
            PG8_WAIT_V(6); PG8_BAR; PG8_MMA(1, 1, At, B1); PG8_BAR;
            }
        }
        if constexpr (ALIGN_EPI) { if (wr == 0) PG8_BAR; }
        if constexpr (!Epi::AFTER_DRAIN) { E(acc, cur, wr, wc, fr, fq); S.done(cur); }
        if (!has_next) break;
#pragma unroll
        for (int a = 0; a < 2; ++a)
#pragma unroll
            for (int b = 0; b < 2; ++b)
#pragma unroll
                for (int m = 0; m < 4; ++m)
#pragma unroll
                    for (int n = 0; n < 2; ++n) acc[a][b][m][n] = (f32x4){0.f, 0.f, 0.f, 0.f};
        cur = nxt; cA = nA; cB = nB; ++ui;
        if constexpr (ALIGN_EPI) { if (wr == 1) PG8_BAR; }
    }
    PG8_WAIT_V(0);
    if constexpr (!ALIGN_EPI) { if (wr == 0) PG8_BAR; }
    PG8_BAR;
    if constexpr (Epi::AFTER_DRAIN) { E.fused(acc, cur, wr, wc, fr, fq, lds, wid, lane); S.done(cur); }
#undef PG8_SA
#undef PG8_SB
#undef PG8_STAGE
#undef PG8_LDA
#undef PG8_LDB
#undef PG8_MMA
#undef PG8_WAIT_V
#undef PG8_WAIT_L
#undef PG8_BAR
#undef PG8_SCHED
}
}

#define LAS __attribute__((address_space(3)))
typedef unsigned short bf16_t;
typedef short bf16x8 __attribute__((ext_vector_type(8)));
typedef float f32x4 __attribute__((ext_vector_type(4)));
typedef float f32x16 __attribute__((ext_vector_type(16)));
typedef unsigned u32x4 __attribute__((ext_vector_type(4)));
typedef unsigned u32x2 __attribute__((ext_vector_type(2)));

constexpr int DM = 1024, TPROMPT = 16384, TSAMPLE = 1024, MROWS = TPROMPT + TSAMPLE;
constexpr int NBB = 18;
constexpr int DFF = 2816, PAST = 4096;
constexpr float EPSV = 1e-6f;
constexpr size_t O_YP = 0, O_YS = 16777216, O_KP = 17825792, O_VP = 26214400, O_SP = 34603008, O_CP = 34734080, O_HP = 34740224,
                 O_KS = 34742272, O_VS = 35266560, O_SS = 35790848, O_CS = 36839424, O_HS = 36888576, O_END = 36904960;
constexpr size_t MiB = 1u << 20;
constexpr size_t WS_MOD = 1 * MiB;
constexpr size_t WS_LB = 2 * MiB;
constexpr size_t WS_WLRU = 2 * MiB + 65536;
constexpr size_t WS_WINE = 3 * MiB;
constexpr size_t WS_WOUTE = 10 * MiB;
constexpr size_t WS_WINO = 12 * MiB;
constexpr size_t WS_WOUTO = 16 * MiB;
constexpr size_t WS_WGU = 18 * MiB;
constexpr size_t WS_WD = 40 * MiB;
constexpr size_t WS_ABUF = 52 * MiB;
constexpr size_t WS_X = 86 * MiB;
constexpr size_t WS_ACT = 154 * MiB;
constexpr size_t WS_UT = WS_ACT, WS_QT = WS_ACT + 70 * MiB;
constexpr size_t WS_P = 248 * MiB;
constexpr size_t WS_QA = WS_P, WS_QB = WS_P + 17 * MiB, WS_KB = WS_P + 34 * MiB, WS_IB = WS_P + 51 * MiB, WS_GB = WS_P + 68 * MiB, WS_LF = WS_P + 85 * MiB;
constexpr size_t WS_GG = WS_P, WS_XBR = WS_P + 34 * MiB, WS_AGGA = WS_P + 102 * MiB, WS_AGGH = WS_P + 104 * MiB;
constexpr size_t WS_LAB = WS_ACT, WS_UUB = WS_ACT + 34 * MiB;
constexpr size_t WS_PART = 368 * MiB;
constexpr size_t WS_OI = 368 * MiB;
constexpr size_t WS_SNT = 402 * MiB;
constexpr size_t WS_DEC = 436 * MiB;
constexpr size_t WS_VT = 438 * MiB;
constexpr size_t WS_KBF = 455 * MiB;
constexpr size_t WS_ABUF2 = 472 * MiB;
constexpr size_t WS_SLOTS = 262144;
constexpr size_t WS_CNT = 32768;
constexpr size_t WS_END = 506 * MiB;
static_assert(WS_QT + (size_t)MROWS * 512 * 2 <= WS_P && WS_LF + (size_t)MROWS * 512 * 4 <= WS_OI && WS_ACT + (size_t)MROWS * DFF * 2 <= WS_P, "ws map");
static_assert(WS_UT + (size_t)1088 * 16384 * 4 <= WS_QT && WS_AGGH + 272 * 1024 * 4 <= WS_OI && WS_X + (size_t)MROWS * 1024 * 4 <= WS_ACT, "ws map 2");

constexpr int NWAVES = 8, NTHREADS = 512;
constexpr int RING_BYTES = 131072, LDS_BYTES = 147456;

#define LDS_WAIT() asm volatile("s_waitcnt lgkmcnt(0)" ::: "memory")
#define LBAR() do { asm volatile("s_waitcnt lgkmcnt(0)" ::: "memory"); __builtin_amdgcn_s_barrier(); asm volatile("" ::: "memory"); } while (0)
__device__ __forceinline__ unsigned pk2(float lo, float hi) { return pg8::cvt_pk_bf16(lo, hi); }
__device__ __forceinline__ float bflo(unsigned w) { return __uint_as_float(w << 16); }
__device__ __forceinline__ float bfhi(unsigned w) { return __uint_as_float(w & 0xffff0000u); }
__device__ __forceinline__ float sigm(float x) { return __builtin_amdgcn_rcpf(1.f + __expf(-x)); }
__device__ __forceinline__ float silu_(float x) { return x * __builtin_amdgcn_rcpf(1.f + __expf(-x)); }
__device__ __forceinline__ float gelu_tanh(float x) { const float u = 0.7978845608028654f * (x + 0.044715f * x * x * x); const float t = 1.f - 2.f * __builtin_amdgcn_rcpf(1.f + __expf(2.f * u)); return 0.5f * x * (1.f + t); }
__device__ __forceinline__ float wave_sum(float v) {
#pragma unroll
    for (int o = 1; o < 64; o <<= 1) v += __shfl_xor(v, o);
    return v;
}
__device__ __forceinline__ bf16x8 cvt8(const f32x4 a, const f32x4 b) {
    u32x4 w; w.x = pk2(a.x, a.y); w.y = pk2(a.z, a.w); w.z = pk2(b.x, b.y); w.w = pk2(b.z, b.w); return __builtin_bit_cast(bf16x8, w);
}
__device__ __forceinline__ int row_bb(int row) { return row < TPROMPT ? (row >> 13) : 2 + ((row - TPROMPT) >> 6); }

struct Args { const float* in[30]; float* out; unsigned char* ws; int ph_lo, ph_hi; };
typedef const __attribute__((address_space(4))) Args* KA;
__device__ __forceinline__ KA kargs() { KA p = (KA)__builtin_amdgcn_kernarg_segment_ptr(); asm volatile("" : "+s"(p)); return p; }

struct EpiInEven {
    static constexpr bool PERM = true, AFTER_DRAIN = false;
    float* out; bf16_t *QA, *QB, *KB, *IB, *GB; float* LF; const float* LB; bf16_t *KBF, *VT;
    __device__ __forceinline__ void operator()(const f32x4 (&acc)[2][2][4][2], const pg8::Unit& u, int wr, int wc, int fr, int fq) const {
        const int typ = u.pn >> 1;
        const int cb = (u.pn & 1) * 256 + wc * 32 + 8 * fq;
#pragma unroll
        for (int ai = 0; ai < 2; ++ai)
#pragma unroll
            for (int m = 0; m < 4; ++m) {
                const int row = u.pm * 256 + ai * 128 + wr * 64 + m * 16 + fr;
#pragma unroll
                for (int bj = 0; bj < 2; ++bj) {
                    const int cc = cb + bj * 128;
                    f32x4 v0 = acc[ai][bj][m][0], v1 = acc[ai][bj][m][1];
                    if (typ == 1 || typ == 2) {
                        float* dst = (row < TPROMPT) ? out + (typ == 1 ? O_KP : O_VP) + (size_t)row * 512 : out + (typ == 1 ? O_KS : O_VS) + (size_t)(row - TPROMPT) * 512;
                        *(f32x4*)(dst + cc) = v0; *(f32x4*)(dst + cc + 4) = v1;
                        if (typ == 1) { u32x4 w; w.x = pk2(v0[0], v0[1]); w.y = pk2(v0[2], v0[3]); w.z = pk2(v1[0], v1[1]); w.w = pk2(v1[2], v1[3]); *(u32x4*)(KBF + (size_t)row * 512 + cc) = w; }
                        else {
                            const int hh = cc >> 6, d0 = cc & 63;
                            bf16_t* vt; int tt;
                            if (row < TPROMPT) { tt = row & 8191; vt = VT + ((size_t)((row >> 13) * 8 + hh) * 64 + d0) * 8192; }
                            else { const int sr = row - TPROMPT; tt = sr & 63; vt = VT + (size_t)16 * 64 * 8192 + ((size_t)((sr >> 6) * 8 + hh) * 64 + d0) * 64; }
                            const int T = (row < TPROMPT) ? 8192 : 64;
                            const int pos = (tt & ~12) | ((tt & 4) << 1) | ((tt & 8) >> 1);
#pragma unroll
                            for (int e = 0; e < 4; ++e) { vt[(size_t)e * T + pos] = (bf16_t)(pk2(v0[e], 0.f) & 0xffffu); vt[(size_t)(4 + e) * T + pos] = (bf16_t)(pk2(v1[e], 0.f) & 0xffffu); }
                        }
                    } else if (typ == 4) {
                        const f32x4 l0 = *(const f32x4*)(LB + cc), l1 = *(const f32x4*)(LB + cc + 4);
                        f32x4 lf0, lf1, k0, k1;
#pragma unroll
                        for (int e = 0; e < 4; ++e) {
                            const float s0 = sigm(v0[e]), s1 = sigm(v1[e]);
                            lf0[e] = __logf(l0[e] + (1.f - l0[e]) * s0); lf1[e] = __logf(l1[e] + (1.f - l1[e]) * s1);
                            k0[e] = (1.f - l0[e]) * (1.f - s0); k1[e] = (1.f - l1[e]) * (1.f - s1);
                        }
                        *(f32x4*)(LF + (size_t)row * 512 + cc) = lf0; *(f32x4*)(LF + (size_t)row * 512 + cc + 4) = lf1;
                        u32x4 w; w.x = pk2(k0[0], k0[1]); w.y = pk2(k0[2], k0[3]); w.z = pk2(k1[0], k1[1]); w.w = pk2(k1[2], k1[3]);
                        *(u32x4*)(KB + (size_t)row * 512 + cc) = w;
                    } else {
                        bf16_t* dst = (typ == 0) ? QA : (typ == 3) ? QB : (typ == 5) ? IB : GB;
                        if (typ == 0) { v0 = v0 * 0.125f; v1 = v1 * 0.125f; }
                        else if (typ == 3) {
#pragma unroll
                            for (int e = 0; e < 4; ++e) { v0[e] = silu_(v0[e]) * 0.08838834764831845f; v1[e] = silu_(v1[e]) * 0.08838834764831845f; }
                        } else if (typ == 6) {
#pragma unroll
                            for (int e = 0; e < 4; ++e) { v0[e] = silu_(v0[e]); v1[e] = silu_(v1[e]); }
                        }
                        u32x4 w; w.x = pk2(v0[0], v0[1]); w.y = pk2(v0[2], v0[3]); w.z = pk2(v1[0], v1[1]); w.w = pk2(v1[2], v1[3]);
                        *(u32x4*)(dst + (size_t)row * 512 + cc) = w;
                    }
                }
            }
    }
};
struct EpiGU {
    static constexpr bool PERM = true, AFTER_DRAIN = false;
    bf16_t* ACT;
    __device__ __forceinline__ void operator()(const f32x4 (&acc)[2][2][4][2], const pg8::Unit& u, int wr, int wc, int fr, int fq) const {
        const int col = u.pn * 128 + wc * 32 + 8 * fq;
#pragma unroll
        for (int ai = 0; ai < 2; ++ai)
#pragma unroll
            for (int m = 0; m < 4; ++m) {
                const int row = u.pm * 256 + ai * 128 + wr * 64 + m * 16 + fr;
                const f32x4 g0 = acc[ai][0][m][0], g1 = acc[ai][0][m][1], u0 = acc[ai][1][m][0], u1 = acc[ai][1][m][1];
                float a[8];
#pragma unroll
                for (int e = 0; e < 4; ++e) { a[e] = silu_(g0[e]) * u0[e]; a[4 + e] = silu_(g1[e]) * u1[e]; }
                u32x4 w; w.x = pk2(a[0], a[1]); w.y = pk2(a[2], a[3]); w.z = pk2(a[4], a[5]); w.w = pk2(a[6], a[7]);
                *(u32x4*)(ACT + (size_t)row * DFF + col) = w;
            }
    }
};
struct EpiRes {
    static constexpr bool PERM = true, AFTER_DRAIN = false;
    const float* xoldP; const float* xoldS; float* xnew; const float* gate;
    __device__ __forceinline__ void operator()(const f32x4 (&acc)[2][2][4][2], const pg8::Unit& u, int wr, int wc, int fr, int fq) const {
#pragma unroll
        for (int ai = 0; ai < 2; ++ai) {
            const int bb = (u.pm < 64) ? (u.pm >> 5) : 2 + (u.pm - 64) * 4 + 2 * ai + wr;
#pragma unroll
            for (int bj = 0; bj < 2; ++bj) {
                const int col = u.pn * 256 + bj * 128 + wc * 32 + 8 * fq;
                const f32x4 g0 = *(const f32x4*)(gate + (size_t)bb * 6144 + col) + 1.f, g1 = *(const f32x4*)(gate + (size_t)bb * 6144 + col + 4) + 1.f;
#pragma unroll
                for (int m = 0; m < 4; ++m) {
                    const int row = u.pm * 256 + ai * 128 + wr * 64 + m * 16 + fr;
                    const float* xo = ((row < TPROMPT) ? xoldP + (size_t)row * DM : xoldS + (size_t)(row - TPROMPT) * DM) + col;
                    float* xn = xnew + (size_t)row * DM + col;
                    const f32x4 a = *(const f32x4*)xo, b = *(const f32x4*)(xo + 4);
                    *(f32x4*)xn = a + g0 * acc[ai][bj][m][0]; *(f32x4*)(xn + 4) = b + g1 * acc[ai][bj][m][1];
                }
            }
        }
    }
};
template <int NSPLIT> struct SplitOrder {
    int G, c;
    __device__ __forceinline__ bool next(int i, pg8::Unit& u) const { const int L = i * G + c; if (L >= 16 * NSPLIT) return false; const int j = L / NSPLIT, sp = L - j * NSPLIT; u.pm = 64 + (j >> 2); u.pn = j & 3; u.kofs = sp * 256; return true; }
    __device__ __forceinline__ void a_ready(const pg8::Unit&) const {}
    __device__ __forceinline__ void done(const pg8::Unit&) const {}
};
struct EpiPart {
    static constexpr bool PERM = true, AFTER_DRAIN = false;
    float* PART;
    __device__ __forceinline__ void operator()(const f32x4 (&acc)[2][2][4][2], const pg8::Unit& u, int wr, int wc, int fr, int fq) const {
        const int sp = u.kofs >> 8;
        float* base = PART + (size_t)sp * TSAMPLE * DM;
#pragma unroll
        for (int ai = 0; ai < 2; ++ai)
#pragma unroll
            for (int m = 0; m < 4; ++m) { const int row = (u.pm - 64) * 256 + ai * 128 + wr * 64 + m * 16 + fr;
#pragma unroll
                for (int bj = 0; bj < 2; ++bj) { const int col = u.pn * 256 + bj * 128 + wc * 32 + 8 * fq;
                    *(f32x4*)(base + (size_t)row * DM + col) = acc[ai][bj][m][0]; *(f32x4*)(base + (size_t)row * DM + col + 4) = acc[ai][bj][m][1]; } }
    }
};
template <bool FIN, bool XBF> struct EpiResNorm {
    static constexpr bool PERM = true, AFTER_DRAIN = true;
    const void* xold; bf16_t* Xw; const float* gate; const float* g; const float* sc; const float* sh; bf16_t* HN; float* OUT; float* slots; unsigned* cnt;
    __device__ __forceinline__ void fused(f32x4 (&acc)[2][2][4][2], const pg8::Unit& u, int wr, int wc, int fr, int fq, PG8_LAS unsigned char* lds, int wid, int lane) const {
        PG8_LAS float* P = (PG8_LAS float*)lds;
        PG8_LAS float* S = (PG8_LAS float*)(lds + 8192);
        const int bb = u.pm >> 5, colb = u.pn * 256 + wc * 32 + 8 * fq;
        {
            f32x4 g4[2][2];
#pragma unroll
            for (int bj = 0; bj < 2; ++bj)
#pragma unroll
                for (int n = 0; n < 2; ++n) g4[bj][n] = *(const f32x4*)(gate + (size_t)bb * 6144 + colb + bj * 128 + 4 * n) + 1.f;
#pragma unroll
            for (int ai = 0; ai < 2; ++ai)
#pragma unroll
                for (int m = 0; m < 4; ++m) { const size_t off = (size_t)(u.pm * 256 + ai * 128 + wr * 64 + m * 16 + fr) * DM + colb; const float* xr = (const float*)xold + off; const bf16_t* xrb = (const bf16_t*)xold + off; bf16_t* xw = Xw + off;
#pragma unroll
                    for (int bj = 0; bj < 2; ++bj) { f32x4 xo0, xo1;
                        if (XBF) { const u32x4 w = *(const u32x4*)(xrb + bj * 128); xo0 = (f32x4){bflo(w.x), bfhi(w.x), bflo(w.y), bfhi(w.y)}; xo1 = (f32x4){bflo(w.z), bfhi(w.z), bflo(w.w), bfhi(w.w)}; }
                        else { xo0 = *(const f32x4*)(xr + bj * 128); xo1 = *(const f32x4*)(xr + bj * 128 + 4); }
                        const f32x4 xn0 = xo0 + g4[bj][0] * acc[ai][bj][m][0], xn1 = xo1 + g4[bj][1] * acc[ai][bj][m][1]; acc[ai][bj][m][0] = xn0; acc[ai][bj][m][1] = xn1;
                        if (!FIN) { u32x4 w; w.x = pk2(xn0.x, xn0.y); w.y = pk2(xn0.z, xn0.w); w.z = pk2(xn1.x, xn1.y); w.w = pk2(xn1.z, xn1.w); *(u32x4*)(xw + bj * 128) = w; } }
                    asm volatile("" : "+v"(acc[ai][0][m][0]), "+v"(acc[ai][0][m][1]), "+v"(acc[ai][1][m][0]), "+v"(acc[ai][1][m][1]));
                    asm volatile("" ::: "memory"); }
        }
#pragma unroll
        for (int ai = 0; ai < 2; ++ai)
#pragma unroll
            for (int m = 0; m < 4; ++m) { float q = 0.f;
#pragma unroll
                for (int bj = 0; bj < 2; ++bj)
#pragma unroll
                    for (int n = 0; n < 2; ++n) { const f32x4 x = acc[ai][bj][m][n]; q += (x[0] * x[0] + x[1] * x[1]) + (x[2] * x[2] + x[3] * x[3]); }
                q += __shfl_xor(q, 16); q += __shfl_xor(q, 32);
                if (fq == 0) P[(ai * 128 + wr * 64 + m * 16 + fr) * 4 + wc] = q; }
        asm volatile("s_waitcnt lgkmcnt(0)" ::: "memory"); __builtin_amdgcn_s_barrier(); asm volatile("" ::: "memory");
        const int row = wid * 32 + (lane & 31);
        if (lane < 32) { const float t = (P[row * 4 + 0] + P[row * 4 + 1]) + (P[row * 4 + 2] + P[row * 4 + 3]);
            __hip_atomic_store(slots + ((size_t)(u.pm * 256 + row) * 4 + u.pn), t, __ATOMIC_RELAXED, __HIP_MEMORY_SCOPE_AGENT); }
        asm volatile("s_waitcnt vmcnt(0)" ::: "memory");
        if (lane == 0) __hip_atomic_fetch_add(cnt + 64 * u.pm, 1u, __ATOMIC_RELAXED, __HIP_MEMORY_SCOPE_AGENT);
        if (wid == 0) { while ((unsigned)__builtin_amdgcn_readfirstlane(__hip_atomic_load(cnt + 64 * u.pm, __ATOMIC_RELAXED, __HIP_MEMORY_SCOPE_AGENT)) < 32u) __builtin_amdgcn_s_sleep(1); }
        asm volatile("s_waitcnt vmcnt(0) lgkmcnt(0)" ::: "memory"); __builtin_amdgcn_s_barrier(); asm volatile("" ::: "memory");
        if (lane < 32) { const float* sl = slots + (size_t)(u.pm * 256 + row) * 4; float t = 0.f;
#pragma unroll
            for (int k = 0; k < 4; ++k) t += __hip_atomic_load(sl + k, __ATOMIC_RELAXED, __HIP_MEMORY_SCOPE_AGENT);
            S[row] = rsqrtf(t * (1.f / DM) + EPSV); }
        asm volatile("s_waitcnt lgkmcnt(0)" ::: "memory"); __builtin_amdgcn_s_barrier(); asm volatile("" ::: "memory");
#pragma unroll
        for (int bj = 0; bj < 2; ++bj) {
            f32x4 gs[2], s0[2];
#pragma unroll
            for (int n = 0; n < 2; ++n) { const int col = colb + bj * 128 + 4 * n; gs[n] = *(const f32x4*)(g + col); s0[n] = (f32x4){0.f, 0.f, 0.f, 0.f};
                if (!FIN) { gs[n] = gs[n] * (*(const f32x4*)(sc + (size_t)bb * 6144 + col) + 1.f); s0[n] = *(const f32x4*)(sh + (size_t)bb * 6144 + col); } }
#pragma unroll
            for (int ai = 0; ai < 2; ++ai)
#pragma unroll
                for (int m = 0; m < 4; ++m) { const int r = ai * 128 + wr * 64 + m * 16 + fr; const size_t off = (size_t)(u.pm * 256 + r) * DM + colb + bj * 128; const float rs = S[r];
                    const f32x4 y0 = acc[ai][bj][m][0] * rs * gs[0] + s0[0], y1 = acc[ai][bj][m][1] * rs * gs[1] + s0[1];
                    if (!FIN) { u32x4 w; w.x = pk2(y0.x, y0.y); w.y = pk2(y0.z, y0.w); w.z = pk2(y1.x, y1.y); w.w = pk2(y1.z, y1.w); *(u32x4*)(HN + off) = w; }
                    else { *(f32x4*)(OUT + off) = y0; *(f32x4*)(OUT + off + 4) = y1; }
                    asm volatile("" ::: "memory"); }
        }
        asm volatile("s_waitcnt lgkmcnt(0)" ::: "memory"); __builtin_amdgcn_s_barrier(); asm volatile("" ::: "memory");
    }
};
struct EpiInOdd {
    static constexpr bool PERM = true, AFTER_DRAIN = false;
    bf16_t* GG; float* XBR;
    __device__ __forceinline__ void operator()(const f32x4 (&acc)[2][2][4][2], const pg8::Unit& u, int wr, int wc, int fr, int fq) const {
        const int typ = u.pn >> 2;
        const int cb = (u.pn & 3) * 256 + wc * 32 + 8 * fq;
#pragma unroll
        for (int ai = 0; ai < 2; ++ai)
#pragma unroll
            for (int m = 0; m < 4; ++m) {
                const int row = u.pm * 256 + ai * 128 + wr * 64 + m * 16 + fr;
#pragma unroll
                for (int bj = 0; bj < 2; ++bj) {
                    const int cc = cb + bj * 128;
                    f32x4 v0 = acc[ai][bj][m][0], v1 = acc[ai][bj][m][1];
                    if (typ == 0) {
#pragma unroll
                        for (int e = 0; e < 4; ++e) { v0[e] = gelu_tanh(v0[e]); v1[e] = gelu_tanh(v1[e]); }
                        u32x4 w; w.x = pk2(v0[0], v0[1]); w.y = pk2(v0[2], v0[3]); w.z = pk2(v1[0], v1[1]); w.w = pk2(v1[2], v1[3]);
                        *(u32x4*)(GG + (size_t)row * DM + cc) = w;
                    } else { *(f32x4*)(XBR + (size_t)row * DM + cc) = v0; *(f32x4*)(XBR + (size_t)row * DM + cc + 4) = v1; }
                }
            }
    }
};

__device__ __forceinline__ void transpose_item(const float* W, int K, int N, bf16_t* WT, int n0, int k0, size_t drow0, LAS float* scr, int lane) {
#pragma unroll 8
    for (int i = 0; i < 32; ++i) { const int kk = 2 * i + (lane >> 5); scr[kk * 33 + (lane & 31)] = W[(size_t)(k0 + kk) * N + n0 + (lane & 31)]; }
    LDS_WAIT(); asm volatile("" ::: "memory");
    const int c = lane & 7;
#pragma unroll
    for (int j = 0; j < 4; ++j) { const int n = (lane >> 3) + 8 * j; const LAS float* s = scr + (8 * c) * 33 + n;
        u32x4 o; o.x = pk2(s[0 * 33], s[1 * 33]); o.y = pk2(s[2 * 33], s[3 * 33]); o.z = pk2(s[4 * 33], s[5 * 33]); o.w = pk2(s[6 * 33], s[7 * 33]);
        *(u32x4*)(WT + (drow0 + n) * (size_t)K + k0 + 8 * c) = o; }
    LDS_WAIT(); asm volatile("" ::: "memory");
}
template <int SET> __device__ __forceinline__ void convert_set(KA A, LAS unsigned char* lds, int lane, int wave, int widx, int nworkers) {
    unsigned char* ws = A->ws;
    LAS float* scr = (LAS float*)(lds + wave * 16384);
#define TJOB(Wp, Kk, Nn, WTp, MODE) { const int cnt = ((Kk) / 64) * ((Nn) / 32); if (r < cnt) { const int nblk = (Nn) / 32, kb_ = r / nblk, nb_ = r % nblk, n0_ = nb_ * 32; \
        const size_t drow_ = (MODE) == 0 ? (size_t)n0_ : (size_t)(256 * (n0_ / 128) + (n0_ % 128) + ((MODE) == 2 ? 128 : 0)); \
        transpose_item((Wp), (Kk), (Nn), (WTp), n0_, kb_ * 64, drow_, scr, lane); continue; } r -= cnt; }
    constexpr int NIT = SET == 0 ? 16 * 112 + 2 * 16 * 88 : SET == 1 ? 16 * 32 + 16 * 64 : SET == 2 ? 44 * 32 : 16 * 32 + 2 * 16 * 88 + 44 * 32 + 16 * 8;
    for (int it = widx; it < NIT; it += nworkers) {
        int r = it;
        if (SET == 0) {
            TJOB(A->in[13], 1024, 3584, (bf16_t*)(ws + WS_WINE), 0)
            TJOB(A->in[26], 1024, 2816, (bf16_t*)(ws + WS_WGU), 1)
            TJOB(A->in[27], 1024, 2816, (bf16_t*)(ws + WS_WGU), 2)
        } else if (SET == 1) {
            TJOB(A->in[14], 1024, 1024, (bf16_t*)(ws + WS_WOUTE), 0)
            TJOB(A->in[17], 1024, 2048, (bf16_t*)(ws + WS_WINO), 0)
        } else if (SET == 2) {
            TJOB(A->in[28], 2816, 1024, (bf16_t*)(ws + WS_WD), 0)
        } else {
            TJOB(A->in[25], 1024, 1024, (bf16_t*)(ws + WS_WOUTO), 0)
            TJOB(A->in[26] + (size_t)1024 * 2816, 1024, 2816, (bf16_t*)(ws + WS_WGU) + (size_t)5632 * 1024, 1)
            TJOB(A->in[27] + (size_t)1024 * 2816, 1024, 2816, (bf16_t*)(ws + WS_WGU) + (size_t)5632 * 1024, 2)
            TJOB(A->in[28] + (size_t)2816 * 1024, 2816, 1024, (bf16_t*)(ws + WS_WD) + (size_t)1024 * 2816, 0)
            { const int h = r >> 3, q = r & 7;
              const float* Wp = (h < 8 ? A->in[20] : A->in[22]) + (size_t)(h & 7) * 16384;
              transpose_item(Wp, 128, 128, (bf16_t*)(ws + WS_WLRU) + (size_t)h * 16384, (q & 3) * 32, (q >> 2) * 64, (size_t)((q & 3) * 32), scr, lane); }
        }
    }
#undef TJOB
}
__device__ __forceinline__ void prologue_phase(KA A, LAS unsigned char* lds, int tid, int lane, int wave) {
    unsigned char* ws = A->ws;
    {
        LAS float* sc = (LAS float*)lds;
        LAS float* red = (LAS float*)(lds + 73728);
        float* MOD = (float*)(ws + WS_MOD);
        bool have_sc = false;
        for (int g = blockIdx.x; g < 192; g += gridDim.x) {
            if (!have_sc) {
                for (int i = tid; i < NBB * 1024; i += NTHREADS) { const int bb = i >> 10, k = i & 1023; const float c = bb < 2 ? A->in[7][bb * 1024 + k] : A->in[8][(bb - 2) * 1024 + k]; sc[i] = silu_(c); }
                have_sc = true;
            }
            __syncthreads();
            const int l = g / 96, cg0 = (g % 96) * 64;
            const float* W = A->in[11] + (size_t)l * 1024 * 6144 + cg0 + lane;
            float acc[NBB];
#pragma unroll
            for (int b = 0; b < NBB; ++b) acc[b] = 0.f;
            const int kb = wave * 128;
#pragma unroll 4
            for (int k4 = 0; k4 < 128; k4 += 4) {
                const float w0 = W[(size_t)(kb + k4) * 6144], w1 = W[(size_t)(kb + k4 + 1) * 6144], w2 = W[(size_t)(kb + k4 + 2) * 6144], w3 = W[(size_t)(kb + k4 + 3) * 6144];
#pragma unroll
                for (int b = 0; b < NBB; ++b) { const f32x4 s = *(const LAS f32x4*)(sc + b * 1024 + kb + k4); acc[b] += s.x * w0 + s.y * w1 + s.z * w2 + s.w * w3; }
            }
#pragma unroll
            for (int b = 0; b < NBB; ++b) red[(wave * NBB + b) * 64 + lane] = acc[b];
            __syncthreads();
            for (int o = tid; o < NBB * 64; o += NTHREADS) { const int bb = o >> 6, cl = o & 63; float s = A->in[12][l * 6144 + cg0 + cl];
#pragma unroll
                for (int w = 0; w < 8; ++w) s += red[(w * NBB + bb) * 64 + cl];
                MOD[(size_t)(l * NBB + bb) * 6144 + cg0 + cl] = s; }
        }
        __syncthreads();
    }
    if (blockIdx.x == gridDim.x - 1) {
        const float* lg = A->in[16]; const int c = tid;
        const float a = lg[c], b = lg[512 + c], d = lg[1024 + c], m = fmaxf(a, fmaxf(b, d));
        const float ea = __expf(a - m), eb = __expf(b - m), ed = __expf(d - m);
        ((float*)(ws + WS_LB))[c] = ea / (ea + eb + ed);
    }
    if (gridDim.x > 192) { const int nw = ((int)gridDim.x + ((int)gridDim.x - 192)) * NWAVES;
        convert_set<0>(A, lds, lane, wave, blockIdx.x * NWAVES + wave, nw);
        if (blockIdx.x >= 192) convert_set<0>(A, lds, lane, wave, ((int)gridDim.x + ((int)blockIdx.x - 192)) * NWAVES + wave, nw); }
    else convert_set<0>(A, lds, lane, wave, blockIdx.x * NWAVES + wave, gridDim.x * NWAVES);
}
template <int SET> __device__ __forceinline__ void convert_in_slack(KA A, LAS unsigned char* lds, int lane, int wave, int nwg) {
    const int G = gridDim.x, maxu = (nwg + G - 1) / G, c0 = nwg - (maxu - 1) * G;
    if (c0 >= G) convert_set<SET>(A, lds, lane, wave, blockIdx.x * NWAVES + wave, G * NWAVES);
    else if ((int)blockIdx.x >= c0) convert_set<SET>(A, lds, lane, wave, ((int)blockIdx.x - c0) * NWAVES + wave, (G - c0) * NWAVES);
}

constexpr int NRB = 4;
__device__ __forceinline__ void norm_mod_phase(const float* xP, const float* xS, const float* g, const float* modl, int shift_i, int scale_i, bf16_t* outb, int lane, int wave,
                                               const float* part, int nsplit, const float* gatev, float* Xs, bool do_prompt, int sgw, int sngw) {
    const int gw = blockIdx.x * NWAVES + wave, NGW = gridDim.x * NWAVES;
    if (do_prompt) for (int row0 = gw * NRB; row0 < TPROMPT; row0 += NGW * NRB) {
        f32x4 v[NRB][4]; float ss[NRB];
#pragma unroll
        for (int r = 0; r < NRB; ++r) { const float* xr = xP + (size_t)(row0 + r) * DM;
#pragma unroll
            for (int j = 0; j < 4; ++j) v[r][j] = *(const f32x4*)(xr + 4 * (lane + 64 * j)); }
        const int bb = row0 >> 13;
        const float* sh = modl + (size_t)bb * 6144 + shift_i * 1024; const float* sc = modl + (size_t)bb * 6144 + scale_i * 1024;
        f32x4 gs[4], s0[4];
#pragma unroll
        for (int j = 0; j < 4; ++j) { const int idx = 4 * (lane + 64 * j); gs[j] = *(const f32x4*)(g + idx) * (*(const f32x4*)(sc + idx) + 1.f); s0[j] = *(const f32x4*)(sh + idx); }
#pragma unroll
        for (int r = 0; r < NRB; ++r) { float a = 0.f;
#pragma unroll
            for (int j = 0; j < 4; ++j) a += (v[r][j].x * v[r][j].x + v[r][j].y * v[r][j].y) + (v[r][j].z * v[r][j].z + v[r][j].w * v[r][j].w);
            ss[r] = a; }
#pragma unroll
        for (int o = 1; o < 64; o <<= 1) {
#pragma unroll
            for (int r = 0; r < NRB; ++r) ss[r] += __shfl_xor(ss[r], o); }
#pragma unroll
        for (int r = 0; r < NRB; ++r) { const float rstd = rsqrtf(ss[r] * (1.f / DM) + EPSV);
#pragma unroll
            for (int j = 0; j < 4; ++j) { const int idx = 4 * (lane + 64 * j);
                const f32x4 y = v[r][j] * rstd * gs[j] + s0[j];
                u32x2 w; w.x = pk2(y.x, y.y); w.y = pk2(y.z, y.w);
                *(u32x2*)(outb + (size_t)(row0 + r) * DM + idx) = w; } }
    }
    for (int sr = sgw; sr < TSAMPLE; sr += sngw) {
        const int bb = 2 + (sr >> 6);
        f32x4 v[4], pa[4];
#pragma unroll
        for (int j = 0; j < 4; ++j) { v[j] = *(const f32x4*)(xS + (size_t)sr * DM + 4 * (lane + 64 * j)); pa[j] = (f32x4){0.f, 0.f, 0.f, 0.f}; }
        for (int sp0 = 0; sp0 < nsplit; sp0 += 6) {
            f32x4 pv[6][4];
#pragma unroll
            for (int q = 0; q < 6; ++q) { const int sp = (sp0 + q < nsplit) ? sp0 + q : sp0;
#pragma unroll
                for (int j = 0; j < 4; ++j) pv[q][j] = *(const f32x4*)(part + ((size_t)sp * TSAMPLE + sr) * DM + 4 * (lane + 64 * j)); }
#pragma unroll
            for (int q = 0; q < 6; ++q) if (sp0 + q < nsplit) {
#pragma unroll
                for (int j = 0; j < 4; ++j) pa[j] = pa[j] + pv[q][j]; } }
        if (nsplit > 0) {
#pragma unroll
            for (int j = 0; j < 4; ++j) { const int idx = 4 * (lane + 64 * j); v[j] = v[j] + (*(const f32x4*)(gatev + (size_t)bb * 6144 + idx) + 1.f) * pa[j];
                if (Xs) *(f32x4*)(Xs + (size_t)sr * DM + idx) = v[j]; } }
        float ss = 0.f;
#pragma unroll
        for (int j = 0; j < 4; ++j) ss += (v[j].x * v[j].x + v[j].y * v[j].y) + (v[j].z * v[j].z + v[j].w * v[j].w);
        const float rstd = rsqrtf(wave_sum(ss) * (1.f / DM) + EPSV);
        if (outb) {
            const float* sh = modl + (size_t)bb * 6144 + shift_i * 1024; const float* sc = modl + (size_t)bb * 6144 + scale_i * 1024;
#pragma unroll
            for (int j = 0; j < 4; ++j) { const int idx = 4 * (lane + 64 * j);
                const f32x4 y = v[j] * rstd * (*(const f32x4*)(g + idx)) * (*(const f32x4*)(sc + idx) + 1.f) + *(const f32x4*)(sh + idx);
                u32x2 w; w.x = pk2(y.x, y.y); w.y = pk2(y.z, y.w);
                *(u32x2*)(outb + (size_t)(TPROMPT + sr) * DM + idx) = w; }
        } else {
#pragma unroll
            for (int j = 0; j < 4; ++j) { const int idx = 4 * (lane + 64 * j); *(f32x4*)(Xs + (size_t)sr * DM + idx) = v[j] * rstd * (*(const f32x4*)(g + idx)); }
        }
    }
}
__device__ __forceinline__ void final_norm_phase(const float* X, const float* g, float* out, int lane, int wave) {
    const int gw = blockIdx.x * NWAVES + wave, NGW = gridDim.x * NWAVES;
    for (int row0 = gw * NRB; row0 < TPROMPT; row0 += NGW * NRB) {
        f32x4 v[NRB][4]; float ss[NRB];
#pragma unroll
        for (int r = 0; r < NRB; ++r) {
#pragma unroll
            for (int j = 0; j < 4; ++j) v[r][j] = *(const f32x4*)(X + (size_t)(row0 + r) * DM + 4 * (lane + 64 * j)); }
        f32x4 gs[4];
#pragma unroll
        for (int j = 0; j < 4; ++j) gs[j] = *(const f32x4*)(g + 4 * (lane + 64 * j));
#pragma unroll
        for (int r = 0; r < NRB; ++r) { float a = 0.f;
#pragma unroll
            for (int j = 0; j < 4; ++j) a += (v[r][j].x * v[r][j].x + v[r][j].y * v[r][j].y) + (v[r][j].z * v[r][j].z + v[r][j].w * v[r][j].w);
            ss[r] = a; }
#pragma unroll
        for (int o = 1; o < 64; o <<= 1) {
#pragma unroll
            for (int r = 0; r < NRB; ++r) ss[r] += __shfl_xor(ss[r], o); }
#pragma unroll
        for (int r = 0; r < NRB; ++r) { const int row = row0 + r; const float rstd = rsqrtf(ss[r] * (1.f / DM) + EPSV);
            float* orow = out + O_YP + (size_t)row * DM;
#pragma unroll
            for (int j = 0; j < 4; ++j) { const int idx = 4 * (lane + 64 * j); *(f32x4*)(orow + idx) = v[r][j] * rstd * gs[j]; } }
    }
}

__device__ __forceinline__ int crow(int r, int hi) { return (r & 3) + 8 * (r >> 2) + 4 * hi; }
__device__ __forceinline__ void sb_attn_phase(KA A, int lane, int wave) {
    const int gw = blockIdx.x * NWAVES + wave, NGW = gridDim.x * NWAVES;
    const int r32 = lane & 31, hi = lane >> 5;
    const bf16_t* QA = (const bf16_t*)(A->ws + WS_QA);
    const bf16_t* KBF = (const bf16_t*)(A->ws + WS_KBF);
    const bf16_t* VT = (const bf16_t*)(A->ws + WS_VT);
    bf16_t* OC = (bf16_t*)(A->ws + WS_ABUF);
    const int sblk0 = (gridDim.x >= 128) ? (int)gridDim.x / 4 : 0;
    const int nprompt_it = (4096 - gw + NGW - 1) / NGW;
    const int sfirst = ((int)blockIdx.x - sblk0) * NWAVES + wave, sstride = ((int)gridDim.x - sblk0) * NWAVES;
    const int nsample_it = (sfirst >= 0 && sfirst < 256) ? (256 - sfirst + sstride - 1) / sstride : 0;
    for (int ui = 0; ui < nprompt_it + nsample_it; ++ui) {
        const int wu = (ui < nprompt_it) ? gw + ui * NGW : 4096 + sfirst + (ui - nprompt_it) * sstride;
        int h, qb, P, qrow0, T; const float *Kpast, *Vpast; const bf16_t *Kn, *Vn;
        if (wu < 4096) { const int b = wu >> 11, rem = wu & 2047; h = rem >> 8; qb = rem & 255; P = 0; T = 8192; qrow0 = b * 8192 + 32 * qb;
            Kn = KBF + (size_t)b * 8192 * 512; Vn = VT + (size_t)(b * 8 + h) * 64 * 8192; Kpast = nullptr; Vpast = nullptr; }
        else { const int su = wu - 4096, bs = su >> 4; h = (su >> 1) & 7; qb = su & 1; P = PAST; T = 64; qrow0 = TPROMPT + bs * 64 + 32 * qb;
            Kn = KBF + (size_t)(TPROMPT + bs * 64) * 512; Vn = VT + (size_t)16 * 64 * 8192 + (size_t)(bs * 8 + h) * 64 * 64;
            Kpast = A->in[2] + (size_t)bs * PAST * 512; Vpast = A->in[3] + (size_t)bs * PAST * 512; }
        const int Q0 = P + 32 * qb, qpos = Q0 + r32;
        bf16x8 qr[4];
#pragma unroll
        for (int d0 = 0; d0 < 4; ++d0) qr[d0] = *(const bf16x8*)(QA + (size_t)(qrow0 + r32) * 512 + h * 64 + d0 * 16 + hi * 8);
        f32x16 o0, o1;
#pragma unroll
        for (int r = 0; r < 16; ++r) { o0[r] = 0.f; o1[r] = 0.f; }
        float carry = 0.f;
        for (int kt = Q0 >> 6; kt >= 0; --kt) {
            const int kb = kt * 64;
            bf16x8 kf[8], vf[8];
            if (kb >= P) {
                const bf16_t* kp = Kn + (size_t)(kb - P + r32) * 512 + h * 64 + hi * 8;
#pragma unroll
                for (int d0 = 0; d0 < 4; ++d0) { kf[2 * d0] = *(const bf16x8*)(kp + d0 * 16); kf[2 * d0 + 1] = *(const bf16x8*)(kp + 32 * 512 + d0 * 16); }
                const bf16_t* vp = Vn + (size_t)r32 * T + (kb - P) + 8 * hi;
#pragma unroll
                for (int jj = 0; jj < 4; ++jj) { vf[2 * jj] = *(const bf16x8*)(vp + 16 * jj); vf[2 * jj + 1] = *(const bf16x8*)(vp + (size_t)32 * T + 16 * jj); }
            } else {
                const float* Kt = Kpast + (size_t)kb * 512; const float* Vt = Vpast + (size_t)kb * 512;
#pragma unroll
                for (int d0 = 0; d0 < 4; ++d0) { const float* k0 = Kt + (size_t)r32 * 512 + h * 64 + d0 * 16 + hi * 8; const float* k1 = k0 + 32 * 512;
                    kf[2 * d0] = cvt8(*(const f32x4*)k0, *(const f32x4*)(k0 + 4)); kf[2 * d0 + 1] = cvt8(*(const f32x4*)k1, *(const f32x4*)(k1 + 4)); }
#pragma unroll
                for (int jj = 0; jj < 4; ++jj) { const float* vb = Vt + (size_t)(32 * (jj >> 1) + 16 * (jj & 1) + 4 * hi) * 512 + h * 64 + r32;
#pragma unroll
                    for (int dd = 0; dd < 2; ++dd) { const float* v = vb + 32 * dd;
                        u32x4 vw; vw.x = pk2(v[0], v[512]); vw.y = pk2(v[1024], v[1536]); vw.z = pk2(v[8 * 512], v[9 * 512]); vw.w = pk2(v[10 * 512], v[11 * 512]);
                        vf[2 * jj + dd] = __builtin_bit_cast(bf16x8, vw); } }
            }
            f32x16 p0, p1;
#pragma unroll
            for (int r = 0; r < 16; ++r) { p0[r] = 0.f; p1[r] = 0.f; }
#pragma unroll
            for (int d0 = 0; d0 < 4; ++d0) {
                p0 = __builtin_amdgcn_mfma_f32_32x32x16_bf16(kf[2 * d0], qr[d0], p0, 0, 0, 0);
                p1 = __builtin_amdgcn_mfma_f32_32x32x16_bf16(kf[2 * d0 + 1], qr[d0], p1, 0, 0, 0);
            }
            f32x16 s0, s1; float G[8];
#pragma unroll
            for (int g = 0; g < 4; ++g) {
                float run0 = 0.f, run1 = 0.f;
#pragma unroll
                for (int e = 3; e >= 0; --e) { const int r = 4 * g + e; const int key = kb + crow(r, hi);
                    const float z0 = p0[r], z1 = p1[r];
                    const float l0 = (key < qpos) ? -(fmaxf(z0, 0.f) + __logf(1.f + __expf(-fabsf(z0)))) : 0.f;
                    const float l1 = (key + 32 < qpos) ? -(fmaxf(z1, 0.f) + __logf(1.f + __expf(-fabsf(z1)))) : 0.f;
                    run0 += l0; run1 += l1; s0[r] = run0; s1[r] = run1; }
                G[g] = run0; G[4 + g] = run1;
            }
            float Gx[8], R[8];
#pragma unroll
            for (int g = 0; g < 8; ++g) Gx[g] = __shfl_xor(G[g], 32);
            float run = 0.f;
#pragma unroll
            for (int g = 7; g >= 0; --g) { R[g] = run; run += G[g] + Gx[g]; }
#pragma unroll
            for (int g = 0; g < 4; ++g) {
                const float off0 = carry + R[g] + (hi == 0 ? Gx[g] : 0.f), off1 = carry + R[4 + g] + (hi == 0 ? Gx[4 + g] : 0.f);
#pragma unroll
                for (int e = 0; e < 4; ++e) { const int r = 4 * g + e; const int key = kb + crow(r, hi);
                    p0[r] = (key < qpos) ? __expf(p0[r] + s0[r] + off0) : 0.f;
                    p1[r] = (key + 32 < qpos) ? __expf(p1[r] + s1[r] + off1) : 0.f; }
            }
            carry += run;
#pragma unroll
            for (int jj = 0; jj < 4; ++jj) {
                u32x4 pw;
                if (jj < 2) { const int b = 8 * jj; pw.x = pk2(p0[b], p0[b + 1]); pw.y = pk2(p0[b + 2], p0[b + 3]); pw.z = pk2(p0[b + 4], p0[b + 5]); pw.w = pk2(p0[b + 6], p0[b + 7]); }
                else { const int b = 8 * (jj - 2); pw.x = pk2(p1[b], p1[b + 1]); pw.y = pk2(p1[b + 2], p1[b + 3]); pw.z = pk2(p1[b + 4], p1[b + 5]); pw.w = pk2(p1[b + 6], p1[b + 7]); }
                const bf16x8 pa = __builtin_bit_cast(bf16x8, pw);
                o0 = __builtin_amdgcn_mfma_f32_32x32x16_bf16(pa, vf[2 * jj], o0, 0, 0, 0);
                o1 = __builtin_amdgcn_mfma_f32_32x32x16_bf16(pa, vf[2 * jj + 1], o1, 0, 0, 0);
            }
            if (__all(carry < -60.f)) break;
        }
        bf16_t* ob = OC + (size_t)qrow0 * DM + h * 64 + r32;
#pragma unroll
        for (int r = 0; r < 16; ++r) { const int q = crow(r, hi); ob[(size_t)q * DM] = (bf16_t)(pk2(o0[r], 0.f) & 0xffffu); ob[(size_t)q * DM + 32] = (bf16_t)(pk2(o1[r], 0.f) & 0xffffu); }
    }
}

__device__ __forceinline__ void hg_item(int it, int& tok0, int& h) { if (it < 1024) { const int b = it >> 9, n = (it >> 2) & 127; h = it & 3; tok0 = b * 8192 + n * 64; } else { const int s = it - 1024; h = s & 3; tok0 = TPROMPT + (s >> 2) * 64; } }
constexpr int HP = 72;
__device__ __forceinline__ unsigned off_b(unsigned row, unsigned ch) { return 256u * row + 16u * (ch ^ (((row & 3) << 2) | ((row >> 2) & 3))); }
__device__ __forceinline__ unsigned tr_addr16(unsigned lane, unsigned c, unsigned ks, unsigned t) { const unsigned g = lane >> 4, q = (lane & 15) >> 2, p = lane & 3; return off_b(32 * ks + 8 * g + 4 * t + q, 2 * c + (p >> 1)) + 8 * (p & 1); }
typedef unsigned short u16x4_t __attribute__((ext_vector_type(4)));
__device__ __forceinline__ bf16x8 tr_frag16(unsigned base, unsigned lane, unsigned c, unsigned ks) {
    u16x4_t r0, r1; const unsigned a0 = base + tr_addr16(lane, c, ks, 0), a1 = base + tr_addr16(lane, c, ks, 1);
    asm volatile("ds_read_b64_tr_b16 %0, %2\n\tds_read_b64_tr_b16 %1, %3\n\ts_waitcnt lgkmcnt(0)" : "=&v"(r0), "=&v"(r1) : "v"(a0), "v"(a1) : "memory");
    return (bf16x8){(short)r0[0], (short)r0[1], (short)r0[2], (short)r0[3], (short)r1[0], (short)r1[1], (short)r1[2], (short)r1[3]};
}
constexpr int RP = 136;
#define HG_PREFETCH(it_) do { int tokP, hP; hg_item((it_), tokP, hP); \
        _Pragma("unroll") for (int i = 0; i < 4; ++i) { const int idx = tid + 512 * i, t = idx >> 5, c4 = idx & 31; lfv[i] = *(const f32x4*)(LF + (size_t)(tokP + t) * 512 + hP * 128 + 4 * c4); } \
        _Pragma("unroll") for (int i = 0; i < 2; ++i) { const int idx = tid + 512 * i, t = idx >> 4, c8 = idx & 15; const size_t o = (size_t)(tokP + t) * 512 + hP * 128 + 8 * c8; \
            ibv[i] = *(const u32x4*)(IB + o); kbv[i] = *(const u32x4*)(KB + o); qbv[i] = *(const u32x4*)(QB + o); } } while (0)
__device__ __forceinline__ void hgrn_a_phase(KA A, LAS unsigned char* lds, int tid, int lane, int wave) {
    unsigned char* ws = A->ws;
    const bf16_t* QB = (const bf16_t*)(ws + WS_QB); const bf16_t* KB = (const bf16_t*)(ws + WS_KB); const bf16_t* IB = (const bf16_t*)(ws + WS_IB);
    const float* LF = (const float*)(ws + WS_LF);
    bf16_t* QT = (bf16_t*)(ws + WS_QT); float* OI = (float*)(ws + WS_OI); float* UT = (float*)(ws + WS_UT); float* DEC = (float*)(ws + WS_DEC);
    LAS float* Lb = (LAS float*)lds;
    LAS unsigned char* Vr = lds + 32768;
    LAS unsigned char* KUr = lds + 51200;
    LAS bf16_t* Pm = (LAS bf16_t*)(lds + 69632);
    LAS bf16_t* Qr = (LAS bf16_t*)(lds + 78848);
    LAS bf16_t* Kr = (LAS bf16_t*)(lds + 96256);
    LAS float* SEGB = (LAS float*)(lds + 113664);
    const int fr = lane & 15, fq = lane >> 4, cc = tid & 127, tq = wave >> 1;
    f32x4 lfv[4]; u32x4 ibv[2], kbv[2], qbv[2];
    int it = blockIdx.x;
    if (it < 1088) HG_PREFETCH(it);
    for (; it < 1088; it += gridDim.x) {
        int tok0, h; hg_item(it, tok0, h);
        f32x4 lfc[4]; u32x4 ibc[2], kbc[2], qbc[2];
#pragma unroll
        for (int i = 0; i < 4; ++i) lfc[i] = lfv[i];
#pragma unroll
        for (int i = 0; i < 2; ++i) { ibc[i] = ibv[i]; kbc[i] = kbv[i]; qbc[i] = qbv[i]; }
        asm volatile("" ::: "memory");
        if (it + (int)gridDim.x < 1088) HG_PREFETCH(it + (int)gridDim.x);
        asm volatile("" ::: "memory");
        LBAR();
#pragma unroll
        for (int i = 0; i < 4; ++i) { const int idx = tid + 512 * i, t = idx >> 5, c4 = idx & 31; *(LAS f32x4*)(Lb + t * 128 + 4 * c4) = lfc[i]; }
#pragma unroll
        for (int i = 0; i < 2; ++i) { const int idx = tid + 512 * i, t = idx >> 4, v8 = idx & 15;
            *(LAS u32x4*)(Vr + off_b(t, v8)) = ibc[i];
            *(LAS u32x4*)(Qr + t * RP + 8 * v8) = qbc[i]; *(LAS u32x4*)(Kr + t * RP + 8 * v8) = kbc[i]; }
        for (int i = tid; i < 64 * HP * 2 / 16; i += NTHREADS) *(LAS u32x4*)((LAS unsigned char*)Pm + 16 * i) = (u32x4){0u, 0u, 0u, 0u};
        LBAR();
        { float run = 0.f;
#pragma unroll
            for (int i = 0; i < 16; ++i) { const int t = 16 * tq + i; run += Lb[t * 128 + cc]; Lb[t * 128 + cc] = run; }
            SEGB[tq * 128 + cc] = run; }
        LBAR();
        if (tq > 0) { float off = 0.f;
#pragma unroll
            for (int sgm = 0; sgm < 3; ++sgm) if (sgm < tq) off += SEGB[sgm * 128 + cc];
#pragma unroll
            for (int i = 0; i < 16; ++i) { const int t = 16 * tq + i; Lb[t * 128 + cc] += off; } }
        LBAR();
#pragma unroll
        for (int i = 0; i < 2; ++i) { const int idx = tid + 512 * i, t = idx >> 4, c8 = idx & 15;
            const u32x4 kw = kbc[i], qw = qbc[i];
            float kf[8] = {bflo(kw.x), bfhi(kw.x), bflo(kw.y), bfhi(kw.y), bflo(kw.z), bfhi(kw.z), bflo(kw.w), bfhi(kw.w)};
            float qf[8] = {bflo(qw.x), bfhi(qw.x), bflo(qw.y), bfhi(qw.y), bflo(qw.z), bfhi(qw.z), bflo(qw.w), bfhi(qw.w)};
            float qo[8];
            float ku[8];
#pragma unroll
            for (int e = 0; e < 8; ++e) { const float bt = Lb[t * 128 + 8 * c8 + e], bl = Lb[63 * 128 + 8 * c8 + e];
                ku[e] = kf[e] * __expf(bl - bt); qo[e] = qf[e] * __expf(bt); }
            { u32x4 kv; kv.x = pk2(ku[0], ku[1]); kv.y = pk2(ku[2], ku[3]); kv.z = pk2(ku[4], ku[5]); kv.w = pk2(ku[6], ku[7]); *(LAS u32x4*)(KUr + off_b(t, c8)) = kv; }
            u32x4 qv; qv.x = pk2(qo[0], qo[1]); qv.y = pk2(qo[2], qo[3]); qv.z = pk2(qo[4], qo[5]); qv.w = pk2(qo[6], qo[7]);
            *(u32x4*)(QT + (size_t)(tok0 + t) * 512 + h * 128 + 8 * c8) = qv; }
        if (tid < 128) DEC[(size_t)it * 128 + tid] = __expf(Lb[63 * 128 + tid]);
        for (int bi = wave; bi < 10; bi += 8) {
            const int I = bi < 1 ? 0 : bi < 3 ? 1 : bi < 6 ? 2 : 3, J = bi - (I * (I + 1)) / 2;
            const int sI = 16 * J + fr, t = 16 * I + fr;
            f32x4 acc = {0.f, 0.f, 0.f, 0.f};
#pragma unroll
            for (int kk = 0; kk < 4; ++kk) {
                const int c0 = 32 * kk + 8 * fq;
                const u32x4 kw = *(const LAS u32x4*)(Kr + sI * RP + c0);
                const u32x4 qw = *(const LAS u32x4*)(Qr + t * RP + c0);
                float kf[8] = {bflo(kw.x), bfhi(kw.x), bflo(kw.y), bfhi(kw.y), bflo(kw.z), bfhi(kw.z), bflo(kw.w), bfhi(kw.w)};
                float qf[8] = {bflo(qw.x), bfhi(qw.x), bflo(qw.y), bfhi(qw.y), bflo(qw.z), bfhi(qw.z), bflo(qw.w), bfhi(qw.w)};
#pragma unroll
                for (int e = 0; e < 8; ++e) { const float BI = (I > 0) ? Lb[(16 * I - 1) * 128 + c0 + e] : 0.f;
                    kf[e] *= __expf(BI - Lb[sI * 128 + c0 + e]); qf[e] *= __expf(Lb[t * 128 + c0 + e] - BI); }
                u32x4 ka, qa; ka.x = pk2(kf[0], kf[1]); ka.y = pk2(kf[2], kf[3]); ka.z = pk2(kf[4], kf[5]); ka.w = pk2(kf[6], kf[7]);
                qa.x = pk2(qf[0], qf[1]); qa.y = pk2(qf[2], qf[3]); qa.z = pk2(qf[4], qf[5]); qa.w = pk2(qf[6], qf[7]);
                acc = __builtin_amdgcn_mfma_f32_16x16x32_bf16(__builtin_bit_cast(bf16x8, ka), __builtin_bit_cast(bf16x8, qa), acc, 0, 0, 0);
            }
            if (I == J) {
#pragma unroll
                for (int j = 0; j < 4; ++j) if (4 * fq + j > fr) acc[j] = 0.f; }
            u32x2 w; w.x = pk2(acc[0], acc[1]); w.y = pk2(acc[2], acc[3]);
            *(LAS u32x2*)(Pm + t * HP + 16 * J + 4 * fq) = w;
        }
        LBAR();
        {
            bf16x8 va[2];
#pragma unroll
            for (int ks = 0; ks < 2; ++ks) va[ks] = tr_frag16((unsigned)(size_t)Vr, (unsigned)lane, (unsigned)wave, (unsigned)ks);
#pragma unroll
            for (int ni = 0; ni < 4; ++ni) { f32x4 acc = {0.f, 0.f, 0.f, 0.f};
#pragma unroll
                for (int ks = 0; ks < 2; ++ks) { const bf16x8 pb = *(const LAS bf16x8*)(Pm + (16 * ni + fr) * HP + 32 * ks + 8 * fq); acc = __builtin_amdgcn_mfma_f32_16x16x32_bf16(va[ks], pb, acc, 0, 0, 0); }
                *(f32x4*)(OI + (size_t)(tok0 + 16 * ni + fr) * 512 + h * 128 + 16 * wave + 4 * fq) = acc; }
#pragma unroll
            for (int ni = 0; ni < 8; ++ni) { f32x4 acc = {0.f, 0.f, 0.f, 0.f};
#pragma unroll
                for (int ks = 0; ks < 2; ++ks) { const bf16x8 kb2 = tr_frag16((unsigned)(size_t)KUr, (unsigned)lane, (unsigned)ni, (unsigned)ks);
                    acc = (it < 1024) ? __builtin_amdgcn_mfma_f32_16x16x32_bf16(kb2, va[ks], acc, 0, 0, 0)
                                      : __builtin_amdgcn_mfma_f32_16x16x32_bf16(va[ks], kb2, acc, 0, 0, 0); }
                if (it < 1024) *(f32x4*)(UT + ((size_t)it * 128 + 16 * wave + fr) * 128 + 16 * ni + 4 * fq) = acc;
                else *(f32x4*)(UT + ((size_t)it * 128 + 16 * ni + fr) * 128 + 16 * wave + 4 * fq) = acc;
                }
        }
    }
    __syncthreads();
}
__device__ __forceinline__ void hgrn_b_phase(KA A, LAS unsigned char* lds, int tid) {
    unsigned char* ws = A->ws;
    const float* __restrict__ UT = (const float*)(ws + WS_UT); const float* __restrict__ DEC = (const float*)(ws + WS_DEC); bf16_t* __restrict__ SNT = (bf16_t*)(ws + WS_SNT);
    LAS float* T = (LAS float*)lds;
    for (int q = (int)blockIdx.x; q < 256; q += gridDim.x) {
        const int s0i = q >> 2, c0 = 32 * (q & 3);
        const size_t it = 1024 + s0i; const float* S0 = A->in[4] + (size_t)s0i * 16384 + c0 * 128; float* So = A->out + O_SS + (size_t)s0i * 16384 + c0 * 128;
        __syncthreads();
#pragma unroll
        for (int i = 0; i < 8; ++i) { const int e = tid + 512 * i, cl = e >> 7, v = e & 127; const float x = S0[e];
            T[cl * 129 + v] = x; So[e] = DEC[it * 128 + c0 + cl] * x + UT[it * 16384 + c0 * 128 + e]; }
        __syncthreads();
#pragma unroll
        for (int i = 0; i < 8; ++i) { const int e = tid + 512 * i, v = e >> 5, cl = e & 31; SNT[it * 16384 + v * 128 + c0 + cl] = (bf16_t)(pk2(T[cl * 129 + v], 0.f) & 0xffffu); }
    }
    const size_t gt = (size_t)blockIdx.x * NTHREADS + tid, GT = (size_t)gridDim.x * NTHREADS;
    for (size_t e = gt; e < 131072; e += GT) {
        const int bh = (int)(e >> 14), vc = (int)(e & 16383), v = vc >> 7, c = vc & 127, b = bh >> 2, h = bh & 3;
        float S = 0.f;
#pragma unroll 32
        for (int n = 0; n < 128; ++n) { const size_t it = (size_t)b * 512 + n * 4 + h;
            SNT[it * 16384 + vc] = (bf16_t)(pk2(S, 0.f) & 0xffffu);
            S = DEC[it * 128 + c] * S + UT[it * 16384 + vc]; }
        A->out[O_SP + ((size_t)(b * 4 + h) * 128 + c) * 128 + v] = S;
    }
}
__device__ __forceinline__ void hgrn_c_phase(KA A, int lane, int wave) {
    unsigned char* ws = A->ws;
    const bf16_t* SNT = (const bf16_t*)(ws + WS_SNT); const bf16_t* QT = (const bf16_t*)(ws + WS_QT); const float* OI = (const float*)(ws + WS_OI);
    const bf16_t* GB = (const bf16_t*)(ws + WS_GB); bf16_t* OC = (bf16_t*)(ws + WS_ABUF); const float* gn = A->in[15];
    const int gw = blockIdx.x * NWAVES + wave, NGW = gridDim.x * NWAVES, fr = lane & 15, fq = lane >> 4;
    for (int wi = gw; wi < 4352; wi += NGW) {
        const int it = wi >> 2, mt = wi & 3; int tok0, h; hg_item(it, tok0, h);
        const int tok = tok0 + 16 * mt + fr;
        f32x4 acc[8];
#pragma unroll
        for (int mi = 0; mi < 8; ++mi) acc[mi] = (f32x4){0.f, 0.f, 0.f, 0.f};
#pragma unroll
        for (int kk = 0; kk < 4; ++kk) {
            const bf16x8 qb = *(const bf16x8*)(QT + (size_t)tok * 512 + h * 128 + 32 * kk + 8 * fq);
#pragma unroll
            for (int mi = 0; mi < 8; ++mi) { const bf16x8 sa = *(const bf16x8*)(SNT + (size_t)it * 16384 + (32 * (mi >> 1) + 8 * (fr >> 2) + 4 * (mi & 1) + (fr & 3)) * 128 + 32 * kk + 8 * fq);
                acc[mi] = __builtin_amdgcn_mfma_f32_16x16x32_bf16(sa, qb, acc[mi], 0, 0, 0); }
        }
        float ss = 0.f;
#pragma unroll
        for (int mi = 0; mi < 8; ++mi) { acc[mi] = acc[mi] + *(const f32x4*)(OI + (size_t)tok * 512 + h * 128 + 32 * (mi >> 1) + 8 * fq + 4 * (mi & 1));
            ss += (acc[mi].x * acc[mi].x + acc[mi].y * acc[mi].y) + (acc[mi].z * acc[mi].z + acc[mi].w * acc[mi].w); }
        ss += __shfl_xor(ss, 16); ss += __shfl_xor(ss, 32);
        const float rstd = rsqrtf(ss * (1.f / 128.f) + EPSV);
#pragma unroll
        for (int mp = 0; mp < 4; ++mp) { const int vcol = h * 128 + 32 * mp + 8 * fq;
            const f32x4 g0 = *(const f32x4*)(gn + vcol), g1 = *(const f32x4*)(gn + vcol + 4); const u32x4 gw4 = *(const u32x4*)(GB + (size_t)tok * 512 + vcol);
            const f32x4 y0 = acc[2 * mp] * rstd * g0, y1 = acc[2 * mp + 1] * rstd * g1;
            u32x4 w; w.x = pk2(y0.x * bflo(gw4.x), y0.y * bfhi(gw4.x)); w.y = pk2(y0.z * bflo(gw4.y), y0.w * bfhi(gw4.y));
            w.z = pk2(y1.x * bflo(gw4.z), y1.y * bfhi(gw4.z)); w.w = pk2(y1.z * bflo(gw4.w), y1.w * bfhi(gw4.w));
            *(u32x4*)(OC + (size_t)tok * DM + 512 + vcol) = w; }
    }
}

constexpr int LP = 129;
__device__ __forceinline__ float neg_expm1(float x) {
    const float p = -x * (1.f + x * (0.5f + x * (0.16666667f + x * (0.041666668f + x * (0.008333334f + x * 0.0013888889f)))));
    return x > -0.25f ? p : 1.f - __expf(x);
}
#define LRU_DECODE(li_, tile_, blk_, prompt_, b_, n_, bs_, srow0_, tloc0_) \
    const int tile_ = (li_) >> 3, blk_ = (li_) & 7; const bool prompt_ = tile_ < 256; const int b_ = tile_ >> 7, n_ = tile_ & 127, bs_ = tile_ - 256; \
    const int srow0_ = prompt_ ? b_ * 8192 : TPROMPT + bs_ * 64; const int tloc0_ = prompt_ ? n_ * 64 : 0;
#define LRU_PREFETCH(li_) do { LRU_DECODE(li_, tileP, blkP, promptP, bP, nP, bsP, srow0P, tloc0P) \
        const int chP = blkP * 128 + c; const int p0P = tloc0P + 16 * tq; \
        const float* cpast = A->in[5]; \
        _Pragma("unroll") for (int hh = 0; hh < 3; ++hh) { const int pp = p0P - 3 + hh; \
            const float* src = (pp >= 0) ? XBR + (size_t)(srow0P + pp) * DM + chP : (promptP ? XBR + chP : cpast + (size_t)(bsP * 3 + 3 + pp) * 1024 + chP); \
            const float vv = *src; xh[hh] = (pp < 0 && promptP) ? 0.f : vv; } \
        _Pragma("unroll") for (int i = 0; i < 16; ++i) xn[i] = XBR[(size_t)(srow0P + p0P + i) * DM + chP]; } while (0)
template <bool UNUSED_>
__device__ __forceinline__ void lru_phase(KA A, LAS unsigned char* lds, int tid, int lane, int wave) {
    unsigned char* ws = A->ws;
    const float* XBR = (const float*)(ws + WS_XBR); const bf16_t* GG = (const bf16_t*)(ws + WS_GG); bf16_t* YIN = (bf16_t*)(ws + WS_ABUF);
    float* AGGA = (float*)(ws + WS_AGGA); float* AGGH = (float*)(ws + WS_AGGH); bf16_t* LAB = (bf16_t*)(ws + WS_LAB); bf16_t* UUB = (bf16_t*)(ws + WS_UUB);
    const bf16_t* WLA = (const bf16_t*)(ws + WS_WLRU); const bf16_t* WLX = WLA + 8 * 16384;
    LAS bf16_t* XCb = (LAS bf16_t*)lds;
    LAS float* XCf = (LAS float*)(lds + 17408);
    LAS float* Af = (LAS float*)(lds + 17408 + 33024);
    LAS float* Uf = (LAS float*)(lds + 17408 + 2 * 33024);
    LAS float* SEG = (LAS float*)(lds + 17408 + 3 * 33024);
    LAS float* SEG2 = SEG + 1024;
    const int fr = lane & 15, fq = lane >> 4, c = tid & 127, tq = wave >> 1;
    float xn[16], xh[3];
    int li = blockIdx.x;
    if (li < 2176) LRU_PREFETCH(li);
    for (; li < 2176; li += gridDim.x) {
        LRU_DECODE(li, tile, blk, prompt, b, n, bs, srow0, tloc0)
        const int ch0 = blk * 128, ch = ch0 + c, tok0 = srow0 + tloc0;
        const bool FIN = !prompt;
        const float cw0 = A->in[18][ch], cw1 = A->in[18][1024 + ch], cw2 = A->in[18][2048 + ch], cw3 = A->in[18][3072 + ch], cb = A->in[19][ch];
        bf16x8 wa[4], wx[4];
#pragma unroll
        for (int kk = 0; kk < 4; ++kk) { wa[kk] = *(const bf16x8*)(WLA + (size_t)blk * 16384 + (16 * wave + fr) * 128 + 32 * kk + 8 * fq);
                                         wx[kk] = *(const bf16x8*)(WLX + (size_t)blk * 16384 + (16 * wave + fr) * 128 + 32 * kk + 8 * fq); }
        float ba4[4], bx4[4], lam4[4];
#pragma unroll
        for (int j = 0; j < 4; ++j) { const int cj = ch0 + 16 * wave + 4 * fq + j; ba4[j] = A->in[21][cj]; bx4[j] = A->in[23][cj]; lam4[j] = A->in[24][cj]; }
        u32x4 gwv[2];
        if (FIN) {
#pragma unroll
            for (int i = 0; i < 2; ++i) { const int idx = tid + 512 * i, t = idx >> 4, c8 = idx & 15; gwv[i] = *(const u32x4*)(GG + (size_t)(tok0 + t) * DM + ch0 + 8 * c8); }
        }
        asm volatile("" ::: "memory");
        float xv[16], xm3 = xh[0], xm2 = xh[1], xm1 = xh[2];
#pragma unroll
        for (int i = 0; i < 16; ++i) xv[i] = xn[i];
        if (li + (int)gridDim.x < 2176) LRU_PREFETCH(li + (int)gridDim.x);
        asm volatile("" ::: "memory");
        LBAR();
#pragma unroll
        for (int i = 0; i < 16; ++i) { const int t = 16 * tq + i; const float x0 = xv[i];
            const float xc = cb + cw0 * xm3 + cw1 * xm2 + cw2 * xm1 + cw3 * x0;
            XCf[t * LP + c] = xc; XCb[t * 136 + c] = (bf16_t)(pk2(xc, 0.f) & 0xffffu);
            xm3 = xm2; xm2 = xm1; xm1 = x0; }
        LBAR();
        {
            f32x4 accA[4], accX[4];
#pragma unroll
            for (int ni = 0; ni < 4; ++ni) { accA[ni] = (f32x4){0.f, 0.f, 0.f, 0.f}; accX[ni] = (f32x4){0.f, 0.f, 0.f, 0.f}; }
#pragma unroll
            for (int kk = 0; kk < 4; ++kk) {
#pragma unroll
                for (int ni = 0; ni < 4; ++ni) { const bf16x8 xb = *(const LAS bf16x8*)(XCb + (16 * ni + fr) * 136 + 32 * kk + 8 * fq);
                    accA[ni] = __builtin_amdgcn_mfma_f32_16x16x32_bf16(wa[kk], xb, accA[ni], 0, 0, 0);
                    accX[ni] = __builtin_amdgcn_mfma_f32_16x16x32_bf16(wx[kk], xb, accX[ni], 0, 0, 0); }
            }
            float L8[4];
#pragma unroll
            for (int j = 0; j < 4; ++j) { const float e = __expf(-lam4[j]); L8[j] = -8.f * (e < 0.01f ? e * (1.f - e * (0.5f - e * 0.33333334f)) : __logf(1.f + e)); }
#pragma unroll
            for (int ni = 0; ni < 4; ++ni) { const int t = 16 * ni + fr;
#pragma unroll
                for (int j = 0; j < 4; ++j) { const int cl = 16 * wave + 4 * fq + j;
                    const float r = sigm(accA[ni][j] + ba4[j]), gi = sigm(accX[ni][j] + bx4[j]);
                    const float la = r * L8[j], a = __expf(la);
                    float mult = __builtin_amdgcn_sqrtf(neg_expm1(2.f * la));
                    if (prompt && n == 0 && t == 0) mult = 1.f;
                    const float xcv = XCf[t * LP + cl]; Af[t * LP + cl] = a; Uf[t * LP + cl] = mult * gi * xcv; if (!FIN) XCf[t * LP + cl] = la; }
            }
        }
        LBAR();
        {
            float Ac = 1.f, hl = 0.f;
#pragma unroll
            for (int i = 0; i < 16; ++i) { const int t = 16 * tq + i; const float a = Af[t * LP + c]; hl = a * hl + Uf[t * LP + c]; Ac *= a; }
            SEG[(tq * 128 + c) * 2] = Ac; SEG[(tq * 128 + c) * 2 + 1] = hl;
        }
        LBAR();
        if (!FIN) {
#pragma unroll
            for (int i = 0; i < 2; ++i) { const int idx = tid + 512 * i, t = idx >> 4, c8 = idx & 15;
                const LAS float* lp = XCf + t * LP + 8 * c8; const LAS float* up = Uf + t * LP + 8 * c8;
                u32x4 w1, w2; w1.x = pk2(lp[0], lp[1]); w1.y = pk2(lp[2], lp[3]); w1.z = pk2(lp[4], lp[5]); w1.w = pk2(lp[6], lp[7]);
                w2.x = pk2(up[0], up[1]); w2.y = pk2(up[2], up[3]); w2.z = pk2(up[4], up[5]); w2.w = pk2(up[6], up[7]);
                *(u32x4*)(LAB + (size_t)(tok0 + t) * DM + ch0 + 8 * c8) = w1; *(u32x4*)(UUB + (size_t)(tok0 + t) * DM + ch0 + 8 * c8) = w2; }
            { const bool last_tile = prompt ? (n == 127) : true;
              if (last_tile && tid < 384) { const int j = tid >> 7; const int T = prompt ? 8192 : 64;
                const float xo = XBR[(size_t)(srow0 + T - 3 + j) * DM + ch];
                if (prompt) A->out[O_CP + (size_t)(b * 3 + j) * 1024 + ch] = xo; else A->out[O_CS + (size_t)(bs * 3 + j) * 1024 + ch] = xo; } }
            if (tq == 0) { float Aa = 1.f, H = 0.f;
#pragma unroll
                for (int s = 0; s < 4; ++s) { const float as = SEG[(s * 128 + c) * 2], hs = SEG[(s * 128 + c) * 2 + 1]; H = as * H + hs; Aa *= as; }
                AGGA[(size_t)tile * 1024 + ch] = Aa; AGGH[(size_t)tile * 1024 + ch] = H; }
        } else {
            float hin;
            hin = A->in[6][(size_t)bs * 1024 + ch];
            float hcur = hin;
#pragma unroll
            for (int s = 0; s < 3; ++s) if (s < tq) hcur = SEG[(s * 128 + c) * 2] * hcur + SEG[(s * 128 + c) * 2 + 1];
#pragma unroll
            for (int i = 0; i < 16; ++i) { const int t = 16 * tq + i; hcur = Af[t * LP + c] * hcur + Uf[t * LP + c]; Uf[t * LP + c] = hcur; }
            const bool last_tile = prompt ? (n == 127) : true;
            if (last_tile && tq == 3) { if (prompt) A->out[O_HP + (size_t)b * 1024 + ch] = hcur; else A->out[O_HS + (size_t)bs * 1024 + ch] = hcur; }
            if (last_tile && tid < 384) { const int j = tid >> 7; const int T = prompt ? 8192 : 64;
                const float xo = XBR[(size_t)(srow0 + T - 3 + j) * DM + ch];
                if (prompt) A->out[O_CP + (size_t)(b * 3 + j) * 1024 + ch] = xo; else A->out[O_CS + (size_t)(bs * 3 + j) * 1024 + ch] = xo; }
            LBAR();
#pragma unroll
            for (int i = 0; i < 2; ++i) { const int idx = tid + 512 * i, t = idx >> 4, c8 = idx & 15;
                const u32x4 gw4 = gwv[i];
                const LAS float* hp = Uf + t * LP + 8 * c8;
                u32x4 w; w.x = pk2(bflo(gw4.x) * hp[0], bfhi(gw4.x) * hp[1]); w.y = pk2(bflo(gw4.y) * hp[2], bfhi(gw4.y) * hp[3]);
                w.z = pk2(bflo(gw4.z) * hp[4], bfhi(gw4.z) * hp[5]); w.w = pk2(bflo(gw4.w) * hp[6], bfhi(gw4.w) * hp[7]);
                *(u32x4*)(YIN + (size_t)(tok0 + t) * DM + ch0 + 8 * c8) = w; }
        }
    }
    __syncthreads();
}

__device__ __forceinline__ void lru_final_phase(KA A, int lane, int wave) {
    unsigned char* ws = A->ws;
    const bf16_t* __restrict__ GG = (const bf16_t*)(ws + WS_GG); bf16_t* __restrict__ YIN = (bf16_t*)(ws + WS_ABUF);
    const float* __restrict__ AGGA = (const float*)(ws + WS_AGGA); const float* __restrict__ AGGH = (const float*)(ws + WS_AGGH);
    const bf16_t* __restrict__ LAB = (const bf16_t*)(ws + WS_LAB); const bf16_t* __restrict__ UUB = (const bf16_t*)(ws + WS_UUB);
    const int gw = blockIdx.x * NWAVES + wave, NGW = gridDim.x * NWAVES;
    for (int wi = gw; wi < 256 * 16; wi += NGW) {
        const int tile = wi >> 4, ch = (wi & 15) * 64 + lane;
        const bool prompt = tile < 256; const int b = tile >> 7, n = tile & 127, bs = tile - 256;
        const int tok0 = prompt ? b * 8192 + n * 64 : TPROMPT + bs * 64;
        float h;
        if (prompt) { h = 0.f; const float* pa = AGGA + (size_t)(b * 128) * 1024 + ch; const float* ph = AGGH + (size_t)(b * 128) * 1024 + ch;
#pragma unroll 16
            for (int np = 0; np < n; ++np) h = pa[(size_t)np * 1024] * h + ph[(size_t)np * 1024]; }
        else h = A->in[6][(size_t)bs * 1024 + ch];
        const size_t o0 = (size_t)tok0 * DM + ch;
#pragma unroll
        for (int g = 0; g < 4; ++g) {
            bf16_t lav[16], uv[16], gv[16];
#pragma unroll
            for (int i = 0; i < 16; ++i) { const size_t o = o0 + (size_t)(16 * g + i) * DM; lav[i] = LAB[o]; uv[i] = UUB[o]; gv[i] = GG[o]; }
#pragma unroll
            for (int i = 0; i < 16; ++i) { const float a = __expf(__uint_as_float((unsigned)lav[i] << 16)); h = a * h + __uint_as_float((unsigned)uv[i] << 16);
                YIN[o0 + (size_t)(16 * g + i) * DM] = (bf16_t)(pk2(__uint_as_float((unsigned)gv[i] << 16) * h, 0.f) & 0xffffu); }
        }
        const bool last_tile = prompt ? (n == 127) : true;
        if (last_tile) { if (prompt) A->out[O_HP + (size_t)b * 1024 + ch] = h; else A->out[O_HS + (size_t)bs * 1024 + ch] = h; }
    }
}

#define XB_XCNT(j)  (256  + 64 * (j))
#define XB_XSUB(j)  (1280 + 64 * (j))
#define XB_XGEN(j)  (2304 + 64 * (j))
#define XB_TOP      3328
#define XB_TOPGEN   3392
#define XCD_BAR_WORDS 3456
__device__ __forceinline__ unsigned xb_ld(unsigned* p)              { return __hip_atomic_load(p, __ATOMIC_RELAXED, __HIP_MEMORY_SCOPE_AGENT); }
__device__ __forceinline__ unsigned xb_add(unsigned* p, unsigned v) { return __hip_atomic_fetch_add(p, v, __ATOMIC_RELAXED, __HIP_MEMORY_SCOPE_AGENT); }
__device__ __forceinline__ unsigned xb_xcc_id() { return (unsigned)__builtin_amdgcn_s_getreg((3 << 11) | 20) & 0xFu; }
__device__ __forceinline__ void xb_census(unsigned* bar, unsigned xcc, volatile LAS unsigned* st) {
    const unsigned G = gridDim.x;
    for (;;) {
        unsigned sum = 0u, cnt = 0u, mine = 0u;
        for (unsigned j = 0; j < 16; ++j) { const unsigned c = xb_ld(&bar[XB_XCNT(j)]); sum += c; cnt += (c > 0u) ? 1u : 0u; mine = (j == xcc) ? c : mine; }
        if (sum == G) { st[0] = mine; st[1] = cnt; break; }
        __builtin_amdgcn_s_sleep(1);
    }
}
template <bool FIRST>
__device__ __forceinline__ void xbar(unsigned* bar, const unsigned xcc, volatile LAS unsigned* st) {
    asm volatile("s_waitcnt vmcnt(0)" ::: "memory");
    __syncthreads();
    if (__builtin_amdgcn_readfirstlane(threadIdx.x >> 6) == 0) {
        const bool l0 = (threadIdx.x == 0);
        __builtin_amdgcn_s_waitcnt(0);
        if (FIRST) { if (l0) xb_census(bar, xcc, st); }
        const unsigned nloc = __builtin_amdgcn_readfirstlane(st[0]), nx = __builtin_amdgcn_readfirstlane(st[1]);
        unsigned old = 0u; if (l0) old = xb_add(&bar[XB_XSUB(xcc)], 1u);
        old = __builtin_amdgcn_readfirstlane(old);
        const unsigned gen = old / nloc;
        if (old + 1u == (gen + 1u) * nloc) {
            __builtin_amdgcn_fence(__ATOMIC_RELEASE, "agent");
            asm volatile("s_waitcnt vmcnt(0)" ::: "memory");
            unsigned og = 0u; if (l0) og = xb_add(&bar[XB_TOP], 1u);
            og = __builtin_amdgcn_readfirstlane(og);
            const unsigned tg = og / nx;
            if (og + 1u == (tg + 1u) * nx) { if (l0) xb_add(&bar[XB_TOPGEN], 1u); }
            else { while (__builtin_amdgcn_readfirstlane(xb_ld(&bar[XB_TOPGEN])) == tg) __builtin_amdgcn_s_sleep(1); }
            __builtin_amdgcn_fence(__ATOMIC_ACQUIRE, "agent");
            if (l0) xb_add(&bar[XB_XGEN(xcc)], 1u);
            asm volatile("s_waitcnt vmcnt(0)" ::: "memory");
        } else {
            while (__builtin_amdgcn_readfirstlane(xb_ld(&bar[XB_XGEN(xcc)])) == gen) __builtin_amdgcn_s_sleep(1);
            __builtin_amdgcn_fence(__ATOMIC_ACQUIRE, "agent");
            asm volatile("s_waitcnt vmcnt(0)" ::: "memory");
        }
    }
    __syncthreads();
}

constexpr int NPHASE = 19;
#define REP_P0 1
#define REP_HA 1
#define REP_SB 1
#define REP_HB 1
#define REP_HC 1
#define REP_L1 1
#define REP_L2 1

#ifndef EN_P0
#define EN_P0 1
#endif
#ifndef EN_HA
#define EN_HA 1
#endif
#ifndef EN_SB
#define EN_SB 1
#endif
#ifndef EN_LRU
#define EN_LRU 1
#endif
#ifndef EN_HC
#define EN_HC 1
#endif

__global__ void __launch_bounds__(NTHREADS, 2) mega_fwd(Args Araw) {
    KA A = kargs();
    extern __shared__ __attribute__((aligned(16))) unsigned char lds_raw[];
    LAS unsigned char* lds = (LAS unsigned char*)lds_raw;
    const int tid = threadIdx.x, lane = tid & 63, wave = __builtin_amdgcn_readfirstlane(tid >> 6);
    unsigned char* ws = A->ws;
    const float* MOD = (const float*)(ws + WS_MOD);
    bf16_t* XB = (bf16_t*)(ws + WS_X);
    float* XSF = (float*)(ws + WS_X + 40 * MiB);
    bf16_t* ABUF = (bf16_t*)(ws + WS_ABUF);
    bf16_t* ABUF2 = (bf16_t*)(ws + WS_ABUF2);
    bf16_t* ACT = (bf16_t*)(ws + WS_ACT);
    const int lo = A->ph_lo, hi = A->ph_hi;
    unsigned* bar = (unsigned*)ws;
    volatile LAS unsigned* st = (volatile LAS unsigned*)(lds + RING_BYTES + 64);
    if (tid < 2) st[tid] = 0u;
    __syncthreads();
    if (hi > 1000) cg::this_grid().sync();
    const unsigned xcc = xb_xcc_id();
    if (tid == 0) (void)xb_add(&bar[XB_XCNT(xcc)], 1u);
#define IN(k) (lo <= (k) && (k) < hi)
#define SEAM(k) do { if (IN(k) && IN((k) + 1)) { if ((k) == 0) xbar<true>(bar, xcc, st); else xbar<false>(bar, xcc, st); } } while (0)
#define MODL(layer) (MOD + (size_t)(layer) * NBB * 6144)
#define GEMM_RES(PH, APTR, WPTR, KK, XOP, XOBF, XWP, LAYER, GI, NG, NSC, NSH, HNP, OUTP, FI) if (IN(PH)) { \
        { pg8::Gemm g{APTR, WPTR, TPROMPT, 1024, KK, KK}; pg8::StaticOrder S; S.init(TPROMPT, 1024, gridDim.x, blockIdx.x); \
          EpiResNorm<(FI) == 3, XOBF> E{XOP, XWP, MODL(LAYER) + (GI) * 1024, NG, NSC, NSH, HNP, OUTP, (float*)(ws + WS_SLOTS), (unsigned*)(ws + WS_CNT) + (FI) * 4096}; \
          pg8::gemm_phase<EpiResNorm<(FI) == 3, XOBF>, pg8::StaticOrder, false, true>(lds, g, S, E); } \
        { pg8::Gemm g{APTR, WPTR, MROWS, 1024, 256, KK}; SplitOrder<(KK) / 256> S{(int)gridDim.x, (int)blockIdx.x}; \
          EpiPart E{(float*)(ws + WS_PART)}; \
          pg8::gemm_phase<EpiPart, SplitOrder<(KK) / 256>, false, true>(lds, g, S, E); } } SEAM(PH);
#define GEMM_GU(PH, LAYER) if (IN(PH)) { \
        pg8::Gemm g{ABUF2, (const bf16_t*)(ws + WS_WGU) + (size_t)(LAYER) * 5632 * 1024, MROWS, 5632, 1024, 1024}; pg8::StaticOrder S; S.init(MROWS, 5632, gridDim.x, blockIdx.x); \
        EpiGU E{ACT}; pg8::gemm_phase<EpiGU, pg8::StaticOrder, true, true>(lds, g, S, E); } SEAM(PH);
    if (IN(0)) { for (int rp = 0; rp < REP_P0; ++rp) prologue_phase(kargs(), lds, tid, lane, wave); } SEAM(0);
    if (IN(1)) norm_mod_phase(A->in[0], A->in[1], A->in[9], MODL(0), 0, 1, ABUF, lane, wave, nullptr, 0, nullptr, nullptr, true, blockIdx.x * NWAVES + wave, gridDim.x * NWAVES); SEAM(1);
    if (IN(2)) {
        pg8::Gemm g{ABUF, (const bf16_t*)(ws + WS_WINE), MROWS, 3584, 1024, 1024}; pg8::StaticOrder S; S.init(MROWS, 3584, gridDim.x, blockIdx.x);
        EpiInEven E{A->out, (bf16_t*)(ws + WS_QA), (bf16_t*)(ws + WS_QB), (bf16_t*)(ws + WS_KB), (bf16_t*)(ws + WS_IB), (bf16_t*)(ws + WS_GB), (float*)(ws + WS_LF), (const float*)(ws + WS_LB), (bf16_t*)(ws + WS_KBF), (bf16_t*)(ws + WS_VT)};
        pg8::gemm_phase<EpiInEven, pg8::StaticOrder, true, true>(lds, g, S, E);
        convert_in_slack<1>(kargs(), lds, lane, wave, (MROWS / 256) * (3584 / 256));
    } SEAM(2);
    if (IN(3)) { for (int rp = 0; rp < REP_HA; ++rp) hgrn_a_phase(kargs(), lds, tid, lane, wave); for (int rp = 0; rp < REP_SB; ++rp) sb_attn_phase(kargs(), lane, wave); } SEAM(3);
    if (IN(4)) { for (int rp = 0; rp < REP_HB; ++rp) hgrn_b_phase(kargs(), lds, tid); } SEAM(4);
    if (IN(5)) { for (int rp = 0; rp < REP_HC; ++rp) hgrn_c_phase(kargs(), lane, wave); } SEAM(5);
    GEMM_RES(6, ABUF, (const bf16_t*)(ws + WS_WOUTE), 1024, A->in[0], false, XB, 0, 2, A->in[10], MODL(0) + 4 * 1024, MODL(0) + 3 * 1024, ABUF2, nullptr, 0)
    if (IN(7)) norm_mod_phase(nullptr, A->in[1], A->in[10], MODL(0), 3, 4, ABUF2, lane, wave, (const float*)(ws + WS_PART), 4, MODL(0) + 2 * 1024, XSF, false, (wave < 4) ? (int)blockIdx.x * 4 + wave : TSAMPLE, (int)gridDim.x * 4); SEAM(7);
    if (IN(8)) { pg8::Gemm g{ABUF2, (const bf16_t*)(ws + WS_WGU), MROWS, 5632, 1024, 1024}; pg8::StaticOrder S; S.init(MROWS, 5632, gridDim.x, blockIdx.x);
        EpiGU E{ACT}; pg8::gemm_phase<EpiGU, pg8::StaticOrder, true, true>(lds, g, S, E);
        convert_in_slack<2>(kargs(), lds, lane, wave, (MROWS / 256) * (5632 / 256)); } SEAM(8);
    GEMM_RES(9, ACT, (const bf16_t*)(ws + WS_WD), DFF, XB, true, XB, 0, 5, A->in[9] + 1024, MODL(1) + 1 * 1024, MODL(1) + 0 * 1024, ABUF2, nullptr, 1)
    if (IN(10)) norm_mod_phase(nullptr, XSF, A->in[9] + 1024, MODL(1), 0, 1, ABUF2, lane, wave, (const float*)(ws + WS_PART), 11, MODL(0) + 5 * 1024, XSF, false, (wave < 4) ? (int)blockIdx.x * 4 + wave : TSAMPLE, (int)gridDim.x * 4); SEAM(10);
    if (IN(11)) {
        pg8::Gemm g{ABUF2, (const bf16_t*)(ws + WS_WINO), MROWS, 2048, 1024, 1024}; pg8::StaticOrder S; S.init(MROWS, 2048, gridDim.x, blockIdx.x);
        EpiInOdd E{(bf16_t*)(ws + WS_GG), (float*)(ws + WS_XBR)};
        pg8::gemm_phase<EpiInOdd, pg8::StaticOrder, true, true>(lds, g, S, E);
        convert_in_slack<3>(kargs(), lds, lane, wave, (MROWS / 256) * (2048 / 256));
    } SEAM(11);
    if (IN(12)) { for (int rp = 0; rp < REP_L1; ++rp) lru_phase<false>(kargs(), lds, tid, lane, wave); } SEAM(12);
    if (IN(13)) { for (int rp = 0; rp < REP_L2; ++rp) lru_final_phase(kargs(), lane, wave); } SEAM(13);
    GEMM_RES(14, ABUF, (const bf16_t*)(ws + WS_WOUTO), 1024, XB, true, XB, 1, 2, A->in[10] + 1024, MODL(1) + 4 * 1024, MODL(1) + 3 * 1024, ABUF2, nullptr, 2)
    if (IN(15)) norm_mod_phase(nullptr, XSF, A->in[10] + 1024, MODL(1), 3, 4, ABUF2, lane, wave, (const float*)(ws + WS_PART), 4, MODL(1) + 2 * 1024, XSF, false, (wave < 4) ? (int)blockIdx.x * 4 + wave : TSAMPLE, (int)gridDim.x * 4); SEAM(15);
    GEMM_GU(16, 1)
    GEMM_RES(17, ACT, (const bf16_t*)(ws + WS_WD) + (size_t)1024 * DFF, DFF, XB, true, nullptr, 1, 5, A->in[29], nullptr, nullptr, nullptr, A->out + O_YP, 3)
    if (IN(18)) norm_mod_phase(nullptr, XSF, A->in[29], MODL(1), 0, 0, nullptr, lane, wave, (const float*)(ws + WS_PART), 11, MODL(1) + 5 * 1024, A->out + O_YS, false, (wave < 4) ? (int)blockIdx.x * 4 + wave : TSAMPLE, (int)gridDim.x * 4);
#undef IN
#undef SEAM
}

#ifndef MK_PER_PHASE
#define MK_PER_PHASE 0
#endif
extern "C" void kernel_launch(void* const* d_in, const int* in_sizes, int n_in, void* d_out, int out_size, void* d_ws, size_t ws_size, hipStream_t stream) {
    static int grid = 0;
    if (grid == 0) {
        if (n_in != 30 || out_size != (int)O_END || ws_size < WS_END) { fprintf(stderr, "kernel_launch: unexpected shapes n_in %d out %d ws %zu\n", n_in, out_size, ws_size); grid = -1; return; }
        int dev = 0, cus = 0, per_cu = 0;
        if (hipGetDevice(&dev) != hipSuccess || hipDeviceGetAttribute(&cus, hipDeviceAttributeMultiprocessorCount, dev) != hipSuccess) { grid = -1; return; }
        if (hipFuncSetAttribute((const void*)mega_fwd, hipFuncAttributeMaxDynamicSharedMemorySize, LDS_BYTES) != hipSuccess) { fprintf(stderr, "kernel_launch: hipFuncSetAttribute failed\n"); grid = -1; return; }
        if (hipOccupancyMaxActiveBlocksPerMultiprocessor(&per_cu, (const void*)mega_fwd, NTHREADS, LDS_BYTES) != hipSuccess || per_cu < 1) { fprintf(stderr, "kernel_launch: occupancy query says %d\n", per_cu); per_cu = 1; }
        (void)hipGetLastError();
        grid = cus >= 256 ? 256 : cus;
        if (grid != 256) fprintf(stderr, "kernel_launch: %d CUs: this build expects 256 workgroups (MI355X)\n", cus);
    }
    if (grid < 0) return;
    Args a{};
    for (int i = 0; i < 30; ++i) a.in[i] = (const float*)d_in[i];
    a.out = (float*)d_out; a.ws = (unsigned char*)d_ws;
#if MK_PER_PHASE
    for (int p = 0; p < NPHASE; ++p) { a.ph_lo = p; a.ph_hi = p + 1; hipLaunchKernelGGL(mega_fwd, dim3(grid), dim3(NTHREADS), LDS_BYTES, stream, a); }
#else
    a.ph_lo = 0; a.ph_hi = NPHASE;
    if (hipMemsetAsync(d_ws, 0, 131072, stream) != hipSuccess) { fprintf(stderr, "kernel_launch: memset of the barrier words failed\n"); return; }
    void* args[] = {&a};
    hipError_t e = hipLaunchCooperativeKernel((const void*)mega_fwd, dim3(grid), dim3(NTHREADS), args, LDS_BYTES, stream);
    if (e != hipSuccess) fprintf(stderr, "cooperative launch failed: %s (grid %d)\n", hipGetErrorString(e), grid);
#endif
}
```

```cpp
#include <hip/hip_runtime.h>
#include <hip/hip_cooperative_groups.h>
#include <cstdio>
#include <cstdint>
namespace cg = cooperative_groups;
namespace pg8 {
#define PG8_LAS __attribute__((address_space(3)))
typedef unsigned short bf16_t;
typedef short bf16x8 __attribute__((ext_vector_type(8)));
typedef float f32x4 __attribute__((ext_vector_type(4)));
typedef unsigned u32x4 __attribute__((ext_vector_type(4)));
constexpr int BM = 256, BK = 64, HALF = 128, HTB = HALF * BK * 2  , STAGE_BYTES = 8 * HTB, NXCD = 8, WGM = 8;

__host__ __device__ __forceinline__ int lds_byte(int r, int c) { const int st = (r >> 4) * 2 + (c >> 5), rr = r & 15, cc = c & 31, ob = rr * 64 + cc * 2; return st * 1024 + (ob ^ (((ob >> 9) & 1) << 5)); }
__host__ __device__ __forceinline__ void stage_rc(int b, int& R, int& C) { const int st = b / 1024, sb = b % 1024, swz = sb ^ (((sb >> 9) & 1) << 5); R = (st >> 1) * 16 + swz / 64; C = (st & 1) * 32 + (swz % 64) / 2; }
__host__ __device__ __forceinline__ int perm32(int rho) { const int n = rho >> 4, i = rho & 15; return 8 * (i >> 2) + 4 * n + (i & 3); }

struct Unit { int pm, pn, kofs; };
struct Gemm { const bf16_t* A; const bf16_t* Bt; int M, N, K, ld; };

struct StaticOrder {
    int nM, nN, nwg, G, c;
    __host__ __device__ void init(int M, int N, int G_, int c_) { nM = M / BM; nN = N / BM; nwg = nM * nN; G = G_; c = c_; }
    __host__ __device__ bool next(int i, Unit& u) const {
        const long L = (long)i * G + c; if (L >= nwg) return false;
        int wgid = (int)L; { const int q = nwg / NXCD, r = nwg % NXCD, xcd = wgid % NXCD, off = wgid / NXCD; wgid = (xcd < r ? xcd * (q + 1) : r * (q + 1) + (xcd - r) * q) + off; }
        const int nig = WGM * nN, gid = wgid / nig, fm = gid * WGM, gsz = (nM - fm) < WGM ? (nM - fm) : WGM;
        u.pm = fm + ((wgid % nig) % gsz); u.pn = (wgid % nig) / gsz; u.kofs = 0; return true;
    }
    __device__ __forceinline__ void a_ready(const Unit&) const {}
    __device__ __forceinline__ void done(const Unit&) const {}
};

__device__ __forceinline__ unsigned cvt_pk_bf16(float lo, float hi) { unsigned r; asm volatile("v_cvt_pk_bf16_f32 %0, %1, %2" : "=v"(r) : "v"(lo), "v"(hi)); return r; }
typedef float f32x2 __attribute__((ext_vector_type(2)));
template <class Epi, class Sched, bool ALIGN_EPI = false, bool SP2 = false>
__device__ __forceinline__ void gemm_phase(PG8_LAS unsigned char* lds, const Gemm g, const Sched& S, const Epi& E) {
    const int tid = threadIdx.x, wid = __builtin_amdgcn_readfirstlane(tid >> 6), lane = tid & 63, wr = wid >> 2, wc = wid & 3, fr = lane & 15, fq = lane >> 4;
    const int K = g.ld, nt = g.K / BK;
    unsigned voffA[2], voffB[2];
#pragma unroll
    for (int i = 0; i < 2; ++i) { int R, C; stage_rc(tid * 16 + i * 8192, R, C); const int Rb = Epi::PERM ? ((R & ~31) + perm32(R & 31)) : R;
        voffA[i] = (unsigned)(R * K + C) * 2u; voffB[i] = (unsigned)(Rb * K + C) * 2u; }
    const size_t kstep = (size_t)(BK * 2);
    const size_t hstep = (size_t)HALF * K * 2;
    const size_t tstep = 2 * hstep;
    const unsigned ldsw = (unsigned)wid * 1024u;
    const int aoff = lds_byte(wr * 64 + fr, fq * 8), boff = lds_byte(wc * 32 + fr, fq * 8);
#define PG8_SA(b, h) (((b) * 2 + (h)) * HTB)
#define PG8_SB(b, h) ((4 + (b) * 2 + (h)) * HTB)
#define PG8_STAGE(bufoff, gbase, voff) do { _Pragma("unroll") for (int _i = 0; _i < 2; ++_i) \
        __builtin_amdgcn_global_load_lds((const unsigned*)((const char*)(gbase) + (voff)[_i]), (PG8_LAS unsigned*)(lds + (bufoff) + ldsw + _i * 8192), 16, 0, 0); } while (0)
#define PG8_LDA(dst, b, h) do { _Pragma("unroll") for (int m = 0; m < 4; ++m) _Pragma("unroll") for (int k = 0; k < 2; ++k) dst[m][k] = *(const PG8_LAS bf16x8*)(lds + PG8_SA(b, h) + aoff + m * 2048 + k * 1024); } while (0)
#define PG8_LDB(dst, b, h) do { _Pragma("unroll") for (int n = 0; n < 2; ++n) _Pragma("unroll") for (int k = 0; k < 2; ++k) dst[n][k] = *(const PG8_LAS bf16x8*)(lds + PG8_SB(b, h) + boff + n * 2048 + k * 1024); } while (0)
#define PG8_MMA(ai, bj, At, Bt) do { __builtin_amdgcn_s_setprio(1); _Pragma("unroll") for (int m = 0; m < 4; ++m) _Pragma("unroll") for (int n = 0; n < 2; ++n) _Pragma("unroll") for (int k = 0; k < 2; ++k) \
        acc[ai][bj][m][n] = __builtin_amdgcn_mfma_f32_16x16x32_bf16(Bt[n][k], At[m][k], acc[ai][bj][m][n], 0, 0, 0); __builtin_amdgcn_s_setprio(0); } while (0)
#define PG8_WAIT_V(n) asm volatile("s_waitcnt vmcnt(" #n ")" ::: "memory")
#define PG8_WAIT_L(n) asm volatile("s_waitcnt lgkmcnt(" #n ")" ::: "memory")
#define PG8_BAR __builtin_amdgcn_s_barrier()
#define PG8_SCHED __builtin_amdgcn_sched_barrier(0)
    Unit cur, nxt; int ui = 0;
    if (!S.next(0, cur)) return;
    f32x4 acc[2][2][4][2];
#pragma unroll
    for (int a = 0; a < 2; ++a)
#pragma unroll
        for (int b = 0; b < 2; ++b)
#pragma unroll
            for (int m = 0; m < 4; ++m)
#pragma unroll
                for (int n = 0; n < 2; ++n) acc[a][b][m][n] = (f32x4){0.f, 0.f, 0.f, 0.f};
    bf16x8 At[4][2], B0[2][2], B1[2][2];
    const char* cA = (const char*)g.A + (size_t)cur.pm * tstep + (size_t)cur.kofs * 2; const char* cB = (const char*)g.Bt + (size_t)cur.pn * tstep + (size_t)cur.kofs * 2;
    S.a_ready(cur);
    if constexpr (SP2) {
        PG8_STAGE(PG8_SB(0, 0), cB, voffB); PG8_STAGE(PG8_SB(0, 1), cB + hstep, voffB); PG8_STAGE(PG8_SA(0, 0), cA, voffA); PG8_STAGE(PG8_SA(0, 1), cA + hstep, voffA);
        if (wr == 1) PG8_BAR;
        PG8_WAIT_V(2); PG8_BAR;
        PG8_STAGE(PG8_SB(1, 0), cB + kstep, voffB); PG8_STAGE(PG8_SA(1, 0), cA + kstep, voffA); PG8_STAGE(PG8_SB(1, 1), cB + hstep + kstep, voffB);
        PG8_WAIT_V(6); PG8_BAR;
    } else {
        PG8_STAGE(PG8_SB(0, 0), cB, voffB); PG8_STAGE(PG8_SA(0, 0), cA, voffA); PG8_STAGE(PG8_SB(0, 1), cB + hstep, voffB); PG8_STAGE(PG8_SA(0, 1), cA + hstep, voffA);
        if (wr == 1) PG8_BAR;
        PG8_WAIT_V(4); PG8_BAR;
        PG8_STAGE(PG8_SB(1, 0), cB + kstep, voffB); PG8_STAGE(PG8_SA(1, 0), cA + kstep, voffA); PG8_STAGE(PG8_SB(1, 1), cB + hstep + kstep, voffB);
        PG8_WAIT_V(6); PG8_BAR;
    }
    for (;;) {
        const bool has_next = S.next(ui + 1, nxt);
        const char* nA = has_next ? (const char*)g.A + (size_t)nxt.pm * tstep + (size_t)nxt.kofs * 2 : cA; const char* nB = has_next ? (const char*)g.Bt + (size_t)nxt.pn * tstep + (size_t)nxt.kofs * 2 : cB;
        for (int t = 0; t < nt; t += 2) {
            const bool last = (t == nt - 2);
            const char* a1 = cA + (size_t)(t + 1) * kstep;
            const char* a2 = last ? nA : cA + (size_t)(t + 2) * kstep; const char* b2 = last ? nB : cB + (size_t)(t + 2) * kstep;
            const char* a3 = a2 + kstep; const char* b3 = b2 + kstep;
            if (last && has_next) S.a_ready(nxt);
            if constexpr (SP2) {
            PG8_LDB(B0, 0, 0); PG8_LDB(B1, 0, 1); PG8_SCHED; PG8_LDA(At, 0, 0); PG8_STAGE(PG8_SA(1, 1), a1 + hstep, voffA);
            PG8_WAIT_V(8); PG8_WAIT_L(0); PG8_BAR; PG8_MMA(0, 0, At, B0); PG8_MMA(0, 1, At, B1); PG8_BAR; PG8_SCHED;
            PG8_LDA(At, 0, 1); PG8_STAGE(PG8_SB(0, 0), b2, voffB); PG8_STAGE(PG8_SB(0, 1), b2 + hstep, voffB); PG8_STAGE(PG8_SA(0, 0), a2, voffA);
            PG8_WAIT_V(8); PG8_WAIT_L(0); PG8_BAR; PG8_MMA(1, 0, At, B0); PG8_MMA(1, 1, At, B1); PG8_BAR; PG8_SCHED;
            PG8_LDB(B0, 1, 0); PG8_LDB(B1, 1, 1); PG8_SCHED; PG8_LDA(At, 1, 0); PG8_STAGE(PG8_SA(0, 1), a2 + hstep, voffA);
            PG8_WAIT_V(8); PG8_WAIT_L(0); PG8_BAR; PG8_MMA(0, 0, At, B0); PG8_MMA(0, 1, At, B1); PG8_BAR; PG8_SCHED;
            PG8_LDA(At, 1, 1); PG8_STAGE(PG8_SB(1, 0), b3, voffB); PG8_STAGE(PG8_SB(1, 1), b3 + hstep, voffB); PG8_STAGE(PG8_SA(1, 0), a3, voffA);
            PG8_WAIT_V(8); PG8_WAIT_L(0); PG8_BAR; PG8_MMA(1, 0, At, B0); PG8_MMA(1, 1, At, B1); PG8_BAR; PG8_SCHED;
            } else {
            PG8_LDB(B0, 0, 0); PG8_SCHED; PG8_LDA(At, 0, 0); PG8_STAGE(PG8_SA(1, 1), a1 + hstep, voffA);
            PG8_WAIT_L(8); PG8_BAR; PG8_WAIT_L(0); PG8_MMA(0, 0, At, B0); PG8_BAR; PG8_SCHED;
            PG8_LDB(B1, 0, 1); PG8_STAGE(PG8_SB(0, 0), b2, voffB);
            PG8_BAR; PG8_WAIT_L(0); PG8_MMA(0, 1, At, B1); PG8_BAR;
            PG8_LDA(At, 0, 1); PG8_STAGE(PG8_SA(0, 0), a2, voffA);
            PG8_BAR; PG8_WAIT_L(0); PG8_MMA(1, 0, At, B0); PG8_BAR; PG8_SCHED;
            PG8_STAGE(PG8_SB(0, 1), b2 + hstep, voffB);
            PG8_WAIT_V(6); PG8_BAR; PG8_MMA(1, 1, At, B1); PG8_BAR;
            PG8_LDB(B0, 1, 0); PG8_SCHED; PG8_LDA(At, 1, 0); PG8_STAGE(PG8_SA(0, 1), a2 + hstep, voffA);
            PG8_WAIT_L(8); PG8_BAR; PG8_WAIT_L(0); PG8_MMA(0, 0, At, B0); PG8_BAR; PG8_SCHED;
            PG8_LDB(B1, 1, 1); PG8_STAGE(PG8_SB(1, 0), b3, voffB);
            PG8_BAR; PG8_WAIT_L(0); PG8_MMA(0, 1, At, B1); PG8_BAR;
            PG8_LDA(At, 1, 1); PG8_STAGE(PG8_SA(1, 0), a3, voffA);
            PG8_BAR; PG8_WAIT_L(0); PG8_MMA(1, 0, At, B0); PG8_BAR; PG8_SCHED;
            PG8_STAGE(PG8_SB(1, 1), b3 + hstep, voffB);
            PG8_WAIT_V(6); PG8_BAR; PG8_MMA(1, 1, At, B1); PG8_BAR;
            }
        }
        if constexpr (ALIGN_EPI) { if (wr == 0) PG8_BAR; }
        if constexpr (!Epi::AFTER_DRAIN) { E(acc, cur, wr, wc, fr, fq); S.done(cur); }
        if (!has_next) break;
#pragma unroll
        for (int a = 0; a < 2; ++a)
#pragma unroll
            for (int b = 0; b < 2; ++b)
#pragma unroll
                for (int m = 0; m < 4; ++m)
#pragma unroll
                    for (int n = 0; n < 2; ++n) acc[a][b][m][n] = (f32x4){0.f, 0.f, 0.f, 0.f};
        cur = nxt; cA = nA; cB = nB; ++ui;
        if constexpr (ALIGN_EPI) { if (wr == 1) PG8_BAR; }
    }
    PG8_WAIT_V(0);
    if constexpr (!ALIGN_EPI) { if (wr == 0) PG8_BAR; }
    PG8_BAR;
    if constexpr (Epi::AFTER_DRAIN) { E.fused(acc, cur, wr, wc, fr, fq, lds, wid, lane); S.done(cur); }
#undef PG8_SA
#undef PG8_SB
#undef PG8_STAGE
#undef PG8_LDA
#undef PG8_LDB
#undef PG8_MMA
#undef PG8_WAIT_V
#undef PG8_WAIT_L
#undef PG8_BAR
#undef PG8_SCHED
}
}

#define LAS __attribute__((address_space(3)))
typedef unsigned short bf16_t;
typedef short bf16x8 __attribute__((ext_vector_type(8)));
typedef float f32x4 __attribute__((ext_vector_type(4)));
typedef float f32x16 __attribute__((ext_vector_type(16)));
typedef unsigned u32x4 __attribute__((ext_vector_type(4)));
typedef unsigned u32x2 __attribute__((ext_vector_type(2)));

constexpr int DM = 1024, TPROMPT = 16384, TSAMPLE = 1024, MROWS = TPROMPT + TSAMPLE;
constexpr int NBB = 18;
constexpr int DFF = 2816, PAST = 4096;
constexpr float EPSV = 1e-6f;
constexpr size_t O_YP = 0, O_YS = 16777216, O_KP = 17825792, O_VP = 26214400, O_SP = 34603008, O_CP = 34734080, O_HP = 34740224,
                 O_KS = 34742272, O_VS = 35266560, O_SS = 35790848, O_CS = 36839424, O_HS = 36888576, O_END = 36904960;
constexpr size_t MiB = 1u << 20;
constexpr size_t WS_MOD = 1 * MiB;
constexpr size_t WS_LB = 2 * MiB;
constexpr size_t WS_WLRU = 2 * MiB + 65536;
constexpr size_t WS_WINE = 3 * MiB;
constexpr size_t WS_WOUTE = 10 * MiB;
constexpr size_t WS_WINO = 12 * MiB;
constexpr size_t WS_WOUTO = 16 * MiB;
constexpr size_t WS_WGU = 18 * MiB;
constexpr size_t WS_WD = 40 * MiB;
constexpr size_t WS_ABUF = 52 * MiB;
constexpr size_t WS_X = 86 * MiB;
constexpr size_t WS_ACT = 154 * MiB;
constexpr size_t WS_UT = WS_ACT, WS_QT = WS_ACT + 70 * MiB;
constexpr size_t WS_P = 248 * MiB;
constexpr size_t WS_QA = WS_P, WS_QB = WS_P + 17 * MiB, WS_KB = WS_P + 34 * MiB, WS_IB = WS_P + 51 * MiB, WS_GB = WS_P + 68 * MiB, WS_LF = WS_P + 85 * MiB;
constexpr size_t WS_GG = WS_P, WS_XBR = WS_P + 34 * MiB, WS_AGGA = WS_P + 102 * MiB, WS_AGGH = WS_P + 104 * MiB;
constexpr size_t WS_LAB = WS_ACT, WS_UUB = WS_ACT + 34 * MiB;
constexpr size_t WS_PART = 368 * MiB;
constexpr size_t WS_OI = 368 * MiB;
constexpr size_t WS_SNT = 402 * MiB;
constexpr size_t WS_DEC = 436 * MiB;
constexpr size_t WS_VT = 438 * MiB;
constexpr size_t WS_KBF = 455 * MiB;
constexpr size_t WS_ABUF2 = 472 * MiB;
constexpr size_t WS_SLOTS = 262144;
constexpr size_t WS_CNT = 32768;
constexpr size_t WS_END = 506 * MiB;
static_assert(WS_QT + (size_t)MROWS * 512 * 2 <= WS_P && WS_LF + (size_t)MROWS * 512 * 4 <= WS_OI && WS_ACT + (size_t)MROWS * DFF * 2 <= WS_P, "ws map");
static_assert(WS_UT + (size_t)1088 * 16384 * 4 <= WS_QT && WS_AGGH + 272 * 1024 * 4 <= WS_OI && WS_X + (size_t)MROWS * 1024 * 4 <= WS_ACT, "ws map 2");

constexpr int NWAVES = 8, NTHREADS = 512;
constexpr int RING_BYTES = 131072, LDS_BYTES = 147456;

#define LDS_WAIT() asm volatile("s_waitcnt lgkmcnt(0)" ::: "memory")
#define LBAR() do { asm volatile("s_waitcnt lgkmcnt(0)" ::: "memory"); __builtin_amdgcn_s_barrier(); asm volatile("" ::: "memory"); } while (0)
__device__ __forceinline__ unsigned pk2(float lo, float hi) { return pg8::cvt_pk_bf16(lo, hi); }
__device__ __forceinline__ float bflo(unsigned w) { return __uint_as_float(w << 16); }
__device__ __forceinline__ float bfhi(unsigned w) { return __uint_as_float(w & 0xffff0000u); }
__device__ __forceinline__ float sigm(float x) { return __builtin_amdgcn_rcpf(1.f + __expf(-x)); }
__device__ __forceinline__ float silu_(float x) { return x * __builtin_amdgcn_rcpf(1.f + __expf(-x)); }
__device__ __forceinline__ float gelu_tanh(float x) { const float u = 0.7978845608028654f * (x + 0.044715f * x * x * x); const float t = 1.f - 2.f * __builtin_amdgcn_rcpf(1.f + __expf(2.f * u)); return 0.5f * x * (1.f + t); }
__device__ __forceinline__ float wave_sum(float v) {
#pragma unroll
    for (int o = 1; o < 64; o <<= 1) v += __shfl_xor(v, o);
    return v;
}
__device__ __forceinline__ bf16x8 cvt8(const f32x4 a, const f32x4 b) {
    u32x4 w; w.x = pk2(a.x, a.y); w.y = pk2(a.z, a.w); w.z = pk2(b.x, b.y); w.w = pk2(b.z, b.w); return __builtin_bit_cast(bf16x8, w);
}
__device__ __forceinline__ int row_bb(int row) { return row < TPROMPT ? (row >> 13) : 2 + ((row - TPROMPT) >> 6); }

struct Args { const float* in[30]; float* out; unsigned char* ws; int ph_lo, ph_hi; };
typedef const __attribute__((address_space(4))) Args* KA;
__device__ __forceinline__ KA kargs() { KA p = (KA)__builtin_amdgcn_kernarg_segment_ptr(); asm volatile("" : "+s"(p)); return p; }

struct EpiInEven {
    static constexpr bool PERM = true, AFTER_DRAIN = false;
    float* out; bf16_t *QA, *QB, *KB, *IB, *GB; float* LF; const float* LB; bf16_t *KBF, *VT;
    __device__ __forceinline__ void operator()(const f32x4 (&acc)[2][2][4][2], const pg8::Unit& u, int wr, int wc, int fr, int fq) const {
        const int typ = u.pn >> 1;
        const int cb = (u.pn & 1) * 256 + wc * 32 + 8 * fq;
#pragma unroll
        for (int ai = 0; ai < 2; ++ai)
#pragma unroll
            for (int m = 0; m < 4; ++m) {
                const int row = u.pm * 256 + ai * 128 + wr * 64 + m * 16 + fr;
#pragma unroll
                for (int bj = 0; bj < 2; ++bj) {
                    const int cc = cb + bj * 128;
                    f32x4 v0 = acc[ai][bj][m][0], v1 = acc[ai][bj][m][1];
                    if (typ == 1 || typ == 2) {
                        float* dst = (row < TPROMPT) ? out + (typ == 1 ? O_KP : O_VP) + (size_t)row * 512 : out + (typ == 1 ? O_KS : O_VS) + (size_t)(row - TPROMPT) * 512;
                        *(f32x4*)(dst + cc) = v0; *(f32x4*)(dst + cc + 4) = v1;
                        if (typ == 1) { u32x4 w; w.x = pk2(v0[0], v0[1]); w.y = pk2(v0[2], v0[3]); w.z = pk2(v1[0], v1[1]); w.w = pk2(v1[2], v1[3]); *(u32x4*)(KBF + (size_t)row * 512 + cc) = w; }
                        else {
                            const int hh = cc >> 6, d0 = cc & 63;
                            bf16_t* vt; int tt;
                            if (row < TPROMPT) { tt = row & 8191; vt = VT + ((size_t)((row >> 13) * 8 + hh) * 64 + d0) * 8192; }
                            else { const int sr = row - TPROMPT; tt = sr & 63; vt = VT + (size_t)16 * 64 * 8192 + ((size_t)((sr >> 6) * 8 + hh) * 64 + d0) * 64; }
                            const int T = (row < TPROMPT) ? 8192 : 64;
                            const int pos = (tt & ~12) | ((tt & 4) << 1) | ((tt & 8) >> 1);
#pragma unroll
                            for (int e = 0; e < 4; ++e) { vt[(size_t)e * T + pos] = (bf16_t)(pk2(v0[e], 0.f) & 0xffffu); vt[(size_t)(4 + e) * T + pos] = (bf16_t)(pk2(v1[e], 0.f) & 0xffffu); }
                        }
                    } else if (typ == 4) {
                        const f32x4 l0 = *(const f32x4*)(LB + cc), l1 = *(const f32x4*)(LB + cc + 4);
                        f32x4 lf0, lf1, k0, k1;
#pragma unroll
                        for (int e = 0; e < 4; ++e) {
                            const float s0 = sigm(v0[e]), s1 = sigm(v1[e]);
                            lf0[e] = __logf(l0[e] + (1.f - l0[e]) * s0); lf1[e] = __logf(l1[e] + (1.f - l1[e]) * s1);
                            k0[e] = (1.f - l0[e]) * (1.f - s0); k1[e] = (1.f - l1[e]) * (1.f - s1);
                        }
                        *(f32x4*)(LF + (size_t)row * 512 + cc) = lf0; *(f32x4*)(LF + (size_t)row * 512 + cc + 4) = lf1;
                        u32x4 w; w.x = pk2(k0[0], k0[1]); w.y = pk2(k0[2], k0[3]); w.z = pk2(k1[0], k1[1]); w.w = pk2(k1[2], k1[3]);
                        *(u32x4*)(KB + (size_t)row * 512 + cc) = w;
                    } else {
                        bf16_t* dst = (typ == 0) ? QA : (typ == 3) ? QB : (typ == 5) ? IB : GB;
                        if (typ == 0) { v0 = v0 * 0.125f; v1 = v1 * 0.125f; }
                        else if (typ == 3) {
#pragma unroll
                            for (int e = 0; e < 4; ++e) { v0[e] = silu_(v0[e]) * 0.08838834764831845f; v1[e] = silu_(v1[e]) * 0.08838834764831845f; }
                        } else if (typ == 6) {
#pragma unroll
                            for (int e = 0; e < 4; ++e) { v0[e] = silu_(v0[e]); v1[e] = silu_(v1[e]); }
                        }
                        u32x4 w; w.x = pk2(v0[0], v0[1]); w.y = pk2(v0[2], v0[3]); w.z = pk2(v1[0], v1[1]); w.w = pk2(v1[2], v1[3]);
                        *(u32x4*)(dst + (size_t)row * 512 + cc) = w;
                    }
                }
            }
    }
};
struct EpiGU {
    static constexpr bool PERM = true, AFTER_DRAIN = false;
    bf16_t* ACT;
    __device__ __forceinline__ void operator()(const f32x4 (&acc)[2][2][4][2], const pg8::Unit& u, int wr, int wc, int fr, int fq) const {
        const int col = u.pn * 128 + wc * 32 + 8 * fq;
#pragma unroll
        for (int ai = 0; ai < 2; ++ai)
#pragma unroll
            for (int m = 0; m < 4; ++m) {
                const int row = u.pm * 256 + ai * 128 + wr * 64 + m * 16 + fr;
                const f32x4 g0 = acc[ai][0][m][0], g1 = acc[ai][0][m][1], u0 = acc[ai][1][m][0], u1 = acc[ai][1][m][1];
                float a[8];
#pragma unroll
                for (int e = 0; e < 4; ++e) { a[e] = silu_(g0[e]) * u0[e]; a[4 + e] = silu_(g1[e]) * u1[e]; }
                u32x4 w; w.x = pk2(a[0], a[1]); w.y = pk2(a[2], a[3]); w.z = pk2(a[4], a[5]); w.w = pk2(a[6], a[7]);
                *(u32x4*)(ACT + (size_t)row * DFF + col) = w;
            }
    }
};
struct EpiRes {
    static constexpr bool PERM = true, AFTER_DRAIN = false;
    const float* xoldP; const float* xoldS; float* xnew; const float* gate;
    __device__ __forceinline__ void operator()(const f32x4 (&acc)[2][2][4][2], const pg8::Unit& u, int wr, int wc, int fr, int fq) const {
#pragma unroll
        for (int ai = 0; ai < 2; ++ai) {
            const int bb = (u.pm < 64) ? (u.pm >> 5) : 2 + (u.pm - 64) * 4 + 2 * ai + wr;
#pragma unroll
            for (int bj = 0; bj < 2; ++bj) {
                const int col = u.pn * 256 + bj * 128 + wc * 32 + 8 * fq;
                const f32x4 g0 = *(const f32x4*)(gate + (size_t)bb * 6144 + col) + 1.f, g1 = *(const f32x4*)(gate + (size_t)bb * 6144 + col + 4) + 1.f;
#pragma unroll
                for (int m = 0; m < 4; ++m) {
                    const int row = u.pm * 256 + ai * 128 + wr * 64 + m * 16 + fr;
                    const float* xo = ((row < TPROMPT) ? xoldP + (size_t)row * DM : xoldS + (size_t)(row - TPROMPT) * DM) + col;
                    float* xn = xnew + (size_t)row * DM + col;
                    const f32x4 a = *(const f32x4*)xo, b = *(const f32x4*)(xo + 4);
                    *(f32x4*)xn = a + g0 * acc[ai][bj][m][0]; *(f32x4*)(xn + 4) = b + g1 * acc[ai][bj][m][1];
                }
            }
        }
    }
};
template <int NSPLIT> struct SplitOrder {
    int G, c;
    __device__ __forceinline__ bool next(int i, pg8::Unit& u) const { const int L = i * G + c; if (L >= 16 * NSPLIT) return false; const int j = L / NSPLIT, sp = L - j * NSPLIT; u.pm = 64 + (j >> 2); u.pn = j & 3; u.kofs = sp * 256; return true; }
    __device__ __forceinline__ void a_ready(const pg8::Unit&) const {}
    __device__ __forceinline__ void done(const pg8::Unit&) const {}
};
struct EpiPart {
    static constexpr bool PERM = true, AFTER_DRAIN = false;
    float* PART;
    __device__ __forceinline__ void operator()(const f32x4 (&acc)[2][2][4][2], const pg8::Unit& u, int wr, int wc, int fr, int fq) const {
        const int sp = u.kofs >> 8;
        float* base = PART + (size_t)sp * TSAMPLE * DM;
#pragma unroll
        for (int ai = 0; ai < 2; ++ai)
#pragma unroll
            for (int m = 0; m < 4; ++m) { const int row = (u.pm - 64) * 256 + ai * 128 + wr * 64 + m * 16 + fr;
#pragma unroll
                for (int bj = 0; bj < 2; ++bj) { const int col = u.pn * 256 + bj * 128 + wc * 32 + 8 * fq;
                    *(f32x4*)(base + (size_t)row * DM + col) = acc[ai][bj][m][0]; *(f32x4*)(base + (size_t)row * DM + col + 4) = acc[ai][bj][m][1]; } }
    }
};
template <bool FIN, bool XBF> struct EpiResNorm {
    static constexpr bool PERM = true, AFTER_DRAIN = true;
    const void* xold; bf16_t* Xw; const float* gate; const float* g; const float* sc; const float* sh; bf16_t* HN; float* OUT; float* slots; unsigned* cnt;
    __device__ __forceinline__ void fused(f32x4 (&acc)[2][2][4][2], const pg8::Unit& u, int wr, int wc, int fr, int fq, PG8_LAS unsigned char* lds, int wid, int lane) const {
        PG8_LAS float* P = (PG8_LAS float*)lds;
        PG8_LAS float* S = (PG8_LAS float*)(lds + 8192);
        const int bb = u.pm >> 5, colb = u.pn * 256 + wc * 32 + 8 * fq;
        {
            f32x4 g4[2][2];
#pragma unroll
            for (int bj = 0; bj < 2; ++bj)
#pragma unroll
                for (int n = 0; n < 2; ++n) g4[bj][n] = *(const f32x4*)(gate + (size_t)bb * 6144 + colb + bj * 128 + 4 * n) + 1.f;
#pragma unroll
            for (int ai = 0; ai < 2; ++ai)
#pragma unroll
                for (int m = 0; m < 4; ++m) { const size_t off = (size_t)(u.pm * 256 + ai * 128 + wr * 64 + m * 16 + fr) * DM + colb; const float* xr = (const float*)xold + off; const bf16_t* xrb = (const bf16_t*)xold + off; bf16_t* xw = Xw + off;
#pragma unroll
                    for (int bj = 0; bj < 2; ++bj) { f32x4 xo0, xo1;
                        if (XBF) { const u32x4 w = *(const u32x4*)(xrb + bj * 128); xo0 = (f32x4){bflo(w.x), bfhi(w.x), bflo(w.y), bfhi(w.y)}; xo1 = (f32x4){bflo(w.z), bfhi(w.z), bflo(w.w), bfhi(w.w)}; }
                        else { xo0 = *(const f32x4*)(xr + bj * 128); xo1 = *(const f32x4*)(xr + bj * 128 + 4); }
                        const f32x4 xn0 = xo0 + g4[bj][0] * acc[ai][bj][m][0], xn1 = xo1 + g4[bj][1] * acc[ai][bj][m][1]; acc[ai][bj][m][0] = xn0; acc[ai][bj][m][1] = xn1;
                        if (!FIN) { u32x4 w; w.x = pk2(xn0.x, xn0.y); w.y = pk2(xn0.z, xn0.w); w.z = pk2(xn1.x, xn1.y); w.w = pk2(xn1.z, xn1.w); *(u32x4*)(xw + bj * 128) = w; } }
                    asm volatile("" : "+v"(acc[ai][0][m][0]), "+v"(acc[ai][0][m][1]), "+v"(acc[ai][1][m][0]), "+v"(acc[ai][1][m][1]));
                    asm volatile("" ::: "memory"); }
        }
#pragma unroll
        for (int ai = 0; ai < 2; ++ai)
#pragma unroll
            for (int m = 0; m < 4; ++m) { float q = 0.f;
#pragma unroll
                for (int bj = 0; bj < 2; ++bj)
#pragma unroll
                    for (int n = 0; n < 2; ++n) { const f32x4 x = acc[ai][bj][m][n]; q += (x[0] * x[0] + x[1] * x[1]) + (x[2] * x[2] + x[3] * x[3]); }
                q += __shfl_xor(q, 16); q += __shfl_xor(q, 32);
                if (fq == 0) P[(ai * 128 + wr * 64 + m * 16 + fr) * 4 + wc] = q; }
        asm volatile("s_waitcnt lgkmcnt(0)" ::: "memory"); __builtin_amdgcn_s_barrier(); asm volatile("" ::: "memory");
        const int row = wid * 32 + (lane & 31);
        if (lane < 32) { const float t = (P[row * 4 + 0] + P[row * 4 + 1]) + (P[row * 4 + 2] + P[row * 4 + 3]);
            __hip_atomic_store(slots + ((size_t)(u.pm * 256 + row) * 4 + u.pn), t, __ATOMIC_RELAXED, __HIP_MEMORY_SCOPE_AGENT); }
        asm volatile("s_waitcnt vmcnt(0)" ::: "memory");
        if (lane == 0) __hip_atomic_fetch_add(cnt + 64 * u.pm, 1u, __ATOMIC_RELAXED, __HIP_MEMORY_SCOPE_AGENT);
        if (wid == 0) { while ((unsigned)__builtin_amdgcn_readfirstlane(__hip_atomic_load(cnt + 64 * u.pm, __ATOMIC_RELAXED, __HIP_MEMORY_SCOPE_AGENT)) < 32u) __builtin_amdgcn_s_sleep(1); }
        asm volatile("s_waitcnt vmcnt(0) lgkmcnt(0)" ::: "memory"); __builtin_amdgcn_s_barrier(); asm volatile("" ::: "memory");
        if (lane < 32) { const float* sl = slots + (size_t)(u.pm * 256 + row) * 4; float t = 0.f;
#pragma unroll
            for (int k = 0; k < 4; ++k) t += __hip_atomic_load(sl + k, __ATOMIC_RELAXED, __HIP_MEMORY_SCOPE_AGENT);
            S[row] = rsqrtf(t * (1.f / DM) + EPSV); }
        asm volatile("s_waitcnt lgkmcnt(0)" ::: "memory"); __builtin_amdgcn_s_barrier(); asm volatile("" ::: "memory");
#pragma unroll
        for (int bj = 0; bj < 2; ++bj) {
            f32x4 gs[2], s0[2];
#pragma unroll
            for (int n = 0; n < 2; ++n) { const int col = colb + bj * 128 + 4 * n; gs[n] = *(const f32x4*)(g + col); s0[n] = (f32x4){0.f, 0.f, 0.f, 0.f};
                if (!FIN) { gs[n] = gs[n] * (*(const f32x4*)(sc + (size_t)bb * 6144 + col) + 1.f); s0[n] = *(const f32x4*)(sh + (size_t)bb * 6144 + col); } }
#pragma unroll
            for (int ai = 0; ai < 2; ++ai)
#pragma unroll
                for (int m = 0; m < 4; ++m) { const int r = ai * 128 + wr * 64 + m * 16 + fr; const size_t off = (size_t)(u.pm * 256 + r) * DM + colb + bj * 128; const float rs = S[r];
                    const f32x4 y0 = acc[ai][bj][m][0] * rs * gs[0] + s0[0], y1 = acc[ai][bj][m][1] * rs * gs[1] + s0[1];
                    if (!FIN) { u32x4 w; w.x = pk2(y0.x, y0.y); w.y = pk2(y0.z, y0.w); w.z = pk2(y1.x, y1.y); w.w = pk2(y1.z, y1.w); *(u32x4*)(HN + off) = w; }
                    else { *(f32x4*)(OUT + off) = y0; *(f32x4*)(OUT + off + 4) = y1; }
                    asm volatile("" ::: "memory"); }
        }
        asm volatile("s_waitcnt lgkmcnt(0)" ::: "memory"); __builtin_amdgcn_s_barrier(); asm volatile("" ::: "memory");
    }
};
struct EpiInOdd {
    static constexpr bool PERM = true, AFTER_DRAIN = false;
    bf16_t* GG; float* XBR;
    __device__ __forceinline__ void operator()(const f32x4 (&acc)[2][2][4][2], const pg8::Unit& u, int wr, int wc, int fr, int fq) const {
        const int typ = u.pn >> 2;
        const int cb = (u.pn & 3) * 256 + wc * 32 + 8 * fq;
#pragma unroll
        for (int ai = 0; ai < 2; ++ai)
#pragma unroll
            for (int m = 0; m < 4; ++m) {
                const int row = u.pm * 256 + ai * 128 + wr * 64 + m * 16 + fr;
#pragma unroll
                for (int bj = 0; bj < 2; ++bj) {
                    const int cc = cb + bj * 128;
                    f32x4 v0 = acc[ai][bj][m][0], v1 = acc[ai][bj][m][1];
                    if (typ == 0) {
#pragma unroll
                        for (int e = 0; e < 4; ++e) { v0[e] = gelu_tanh(v0[e]); v1[e] = gelu_tanh(v1[e]); }
                        u32x4 w; w.x = pk2(v0[0], v0[1]); w.y = pk2(v0[2], v0[3]); w.z = pk2(v1[0], v1[1]); w.w = pk2(v1[2], v1[3]);
                        *(u32x4*)(GG + (size_t)row * DM + cc) = w;
                    } else { *(f32x4*)(XBR + (size_t)row * DM + cc) = v0; *(f32x4*)(XBR + (size_t)row * DM + cc + 4) = v1; }
                }
            }
    }
};

__device__ __forceinline__ void transpose_item(const float* W, int K, int N, bf16_t* WT, int n0, int k0, size_t drow0, LAS float* scr, int lane) {
#pragma unroll 8
    for (int i = 0; i < 32; ++i) { const int kk = 2 * i + (lane >> 5); scr[kk * 33 + (lane & 31)] = W[(size_t)(k0 + kk) * N + n0 + (lane & 31)]; }
    LDS_WAIT(); asm volatile("" ::: "memory");
    const int c = lane & 7;
#pragma unroll
    for (int j = 0; j < 4; ++j) { const int n = (lane >> 3) + 8 * j; const LAS float* s = scr + (8 * c) * 33 + n;
        u32x4 o; o.x = pk2(s[0 * 33], s[1 * 33]); o.y = pk2(s[2 * 33], s[3 * 33]); o.z = pk2(s[4 * 33], s[5 * 33]); o.w = pk2(s[6 * 33], s[7 * 33]);
        *(u32x4*)(WT + (drow0 + n) * (size_t)K + k0 + 8 * c) = o; }
    LDS_WAIT(); asm volatile("" ::: "memory");
}
template <int SET> __device__ __forceinline__ void convert_set(KA A, LAS unsigned char* lds, int lane, int wave, int widx, int nworkers) {
    unsigned char* ws = A->ws;
    LAS float* scr = (LAS float*)(lds + wave * 16384);
#define TJOB(Wp, Kk, Nn, WTp, MODE) { const int cnt = ((Kk) / 64) * ((Nn) / 32); if (r < cnt) { const int nblk = (Nn) / 32, kb_ = r / nblk, nb_ = r % nblk, n0_ = nb_ * 32; \
        const size_t drow_ = (MODE) == 0 ? (size_t)n0_ : (size_t)(256 * (n0_ / 128) + (n0_ % 128) + ((MODE) == 2 ? 128 : 0)); \
        transpose_item((Wp), (Kk), (Nn), (WTp), n0_, kb_ * 64, drow_, scr, lane); continue; } r -= cnt; }
    constexpr int NIT = SET == 0 ? 16 * 112 + 2 * 16 * 88 : SET == 1 ? 16 * 32 + 16 * 64 : SET == 2 ? 44 * 32 : 16 * 32 + 2 * 16 * 88 + 44 * 32 + 16 * 8;
    for (int it = widx; it < NIT; it += nworkers) {
        int r = it;
        if (SET == 0) {
            TJOB(A->in[13], 1024, 3584, (bf16_t*)(ws + WS_WINE), 0)
            TJOB(A->in[26], 1024, 2816, (bf16_t*)(ws + WS_WGU), 1)
            TJOB(A->in[27], 1024, 2816, (bf16_t*)(ws + WS_WGU), 2)
        } else if (SET == 1) {
            TJOB(A->in[14], 1024, 1024, (bf16_t*)(ws + WS_WOUTE), 0)
            TJOB(A->in[17], 1024, 2048, (bf16_t*)(ws + WS_WINO), 0)
        } else if (SET == 2) {
            TJOB(A->in[28], 2816, 1024, (bf16_t*)(ws + WS_WD), 0)
        } else {
            TJOB(A->in[25], 1024, 1024, (bf16_t*)(ws + WS_WOUTO), 0)
            TJOB(A->in[26] + (size_t)1024 * 2816, 1024, 2816, (bf16_t*)(ws + WS_WGU) + (size_t)5632 * 1024, 1)
            TJOB(A->in[27] + (size_t)1024 * 2816, 1024, 2816, (bf16_t*)(ws + WS_WGU) + (size_t)5632 * 1024, 2)
            TJOB(A->in[28] + (size_t)2816 * 1024, 2816, 1024, (bf16_t*)(ws + WS_WD) + (size_t)1024 * 2816, 0)
            { const int h = r >> 3, q = r & 7;
              const float* Wp = (h < 8 ? A->in[20] : A->in[22]) + (size_t)(h & 7) * 16384;
              transpose_item(Wp, 128, 128, (bf16_t*)(ws + WS_WLRU) + (size_t)h * 16384, (q & 3) * 32, (q >> 2) * 64, (size_t)((q & 3) * 32), scr, lane); }
        }
    }
#undef TJOB
}
__device__ __forceinline__ void prologue_phase(KA A, LAS unsigned char* lds, int tid, int lane, int wave) {
    unsigned char* ws = A->ws;
    {
        LAS float* sc = (LAS float*)lds;
        LAS float* red = (LAS float*)(lds + 73728);
        float* MOD = (float*)(ws + WS_MOD);
        bool have_sc = false;
        for (int g = blockIdx.x; g < 192; g += gridDim.x) {
            if (!have_sc) {
                for (int i = tid; i < NBB * 1024; i += NTHREADS) { const int bb = i >> 10, k = i & 1023; const float c = bb < 2 ? A->in[7][bb * 1024 + k] : A->in[8][(bb - 2) * 1024 + k]; sc[i] = silu_(c); }
                have_sc = true;
            }
            __syncthreads();
            const int l = g / 96, cg0 = (g % 96) * 64;
            const float* W = A->in[11] + (size_t)l * 1024 * 6144 + cg0 + lane;
            float acc[NBB];
#pragma unroll
            for (int b = 0; b < NBB; ++b) acc[b] = 0.f;
            const int kb = wave * 128;
#pragma unroll 4
            for (int k4 = 0; k4 < 128; k4 += 4) {
                const float w0 = W[(size_t)(kb + k4) * 6144], w1 = W[(size_t)(kb + k4 + 1) * 6144], w2 = W[(size_t)(kb + k4 + 2) * 6144], w3 = W[(size_t)(kb + k4 + 3) * 6144];
#pragma unroll
                for (int b = 0; b < NBB; ++b) { const f32x4 s = *(const LAS f32x4*)(sc + b * 1024 + kb + k4); acc[b] += s.x * w0 + s.y * w1 + s.z * w2 + s.w * w3; }
            }
#pragma unroll
            for (int b = 0; b < NBB; ++b) red[(wave * NBB + b) * 64 + lane] = acc[b];
            __syncthreads();
            for (int o = tid; o < NBB * 64; o += NTHREADS) { const int bb = o >> 6, cl = o & 63; float s = A->in[12][l * 6144 + cg0 + cl];
#pragma unroll
                for (int w = 0; w < 8; ++w) s += red[(w * NBB + bb) * 64 + cl];
                MOD[(size_t)(l * NBB + bb) * 6144 + cg0 + cl] = s; }
        }
        __syncthreads();
    }
    if (blockIdx.x == gridDim.x - 1) {
        const float* lg = A->in[16]; const int c = tid;
        const float a = lg[c], b = lg[512 + c], d = lg[1024 + c], m = fmaxf(a, fmaxf(b, d));
        const float ea = __expf(a - m), eb = __expf(b - m), ed = __expf(d - m);
        ((float*)(ws + WS_LB))[c] = ea / (ea + eb + ed);
    }
    if (gridDim.x > 192) { const int nw = ((int)gridDim.x + ((int)gridDim.x - 192)) * NWAVES;
        convert_set<0>(A, lds, lane, wave, blockIdx.x * NWAVES + wave, nw);
        if (blockIdx.x >= 192) convert_set<0>(A, lds, lane, wave, ((int)gridDim.x + ((int)blockIdx.x - 192)) * NWAVES + wave, nw); }
    else convert_set<0>(A, lds, lane, wave, blockIdx.x * NWAVES + wave, gridDim.x * NWAVES);
}
template <int SET> __device__ __forceinline__ void convert_in_slack(KA A, LAS unsigned char* lds, int lane, int wave, int nwg) {
    const int G = gridDim.x, maxu = (nwg + G - 1) / G, c0 = nwg - (maxu - 1) * G;
    if (c0 >= G) convert_set<SET>(A, lds, lane, wave, blockIdx.x * NWAVES + wave, G * NWAVES);
    else if ((int)blockIdx.x >= c0) convert_set<SET>(A, lds, lane, wave, ((int)blockIdx.x - c0) * NWAVES + wave, (G - c0) * NWAVES);
}

constexpr int NRB = 4;
__device__ __forceinline__ void norm_mod_phase(const float* xP, const float* xS, const float* g, const float* modl, int shift_i, int scale_i, bf16_t* outb, int lane, int wave,
                                               const float* part, int nsplit, const float* gatev, float* Xs, bool do_prompt, int sgw, int sngw) {
    const int gw = blockIdx.x * NWAVES + wave, NGW = gridDim.x * NWAVES;
    if (do_prompt) for (int row0 = gw * NRB; row0 < TPROMPT; row0 += NGW * NRB) {
        f32x4 v[NRB][4]; float ss[NRB];
#pragma unroll
        for (int r = 0; r < NRB; ++r) { const float* xr = xP + (size_t)(row0 + r) * DM;
#pragma unroll
            for (int j = 0; j < 4; ++j) v[r][j] = *(const f32x4*)(xr + 4 * (lane + 64 * j)); }
        const int bb = row0 >> 13;
        const float* sh = modl + (size_t)bb * 6144 + shift_i * 1024; const float* sc = modl + (size_t)bb * 6144 + scale_i * 1024;
        f32x4 gs[4], s0[4];
#pragma unroll
        for (int j = 0; j < 4; ++j) { const int idx = 4 * (lane + 64 * j); gs[j] = *(const f32x4*)(g + idx) * (*(const f32x4*)(sc + idx) + 1.f); s0[j] = *(const f32x4*)(sh + idx); }
#pragma unroll
        for (int r = 0; r < NRB; ++r) { float a = 0.f;
#pragma unroll
            for (int j = 0; j < 4; ++j) a += (v[r][j].x * v[r][j].x + v[r][j].y * v[r][j].y) + (v[r][j].z * v[r][j].z + v[r][j].w * v[r][j].w);
            ss[r] = a; }
#pragma unroll
        for (int o = 1; o < 64; o <<= 1) {
#pragma unroll
            for (int r = 0; r < NRB; ++r) ss[r] += __shfl_xor(ss[r], o); }
#pragma unroll
        for (int r = 0; r < NRB; ++r) { const float rstd = rsqrtf(ss[r] * (1.f / DM) + EPSV);
#pragma unroll
            for (int j = 0; j < 4; ++j) { const int idx = 4 * (lane + 64 * j);
                const f32x4 y = v[r][j] * rstd * gs[j] + s0[j];
                u32x2 w; w.x = pk2(y.x, y.y); w.y = pk2(y.z, y.w);
                *(u32x2*)(outb + (size_t)(row0 + r) * DM + idx) = w; } }
    }
    for (int sr = sgw; sr < TSAMPLE; sr += sngw) {
        const int bb = 2 + (sr >> 6);
        f32x4 v[4], pa[4];
#pragma unroll
        for (int j = 0; j < 4; ++j) { v[j] = *(const f32x4*)(xS + (size_t)sr * DM + 4 * (lane + 64 * j)); pa[j] = (f32x4){0.f, 0.f, 0.f, 0.f}; }
        for (int sp0 = 0; sp0 < nsplit; sp0 += 4) {
            f32x4 pv[4][4];
#pragma unroll
            for (int q = 0; q < 4; ++q) { const int sp = (sp0 + q < nsplit) ? sp0 + q : sp0;
#pragma unroll
                for (int j = 0; j < 4; ++j) pv[q][j] = *(const f32x4*)(part + ((size_t)sp * TSAMPLE + sr) * DM + 4 * (lane + 64 * j)); }
#pragma unroll
            for (int q = 0; q < 4; ++q) if (sp0 + q < nsplit) {
#pragma unroll
                for (int j = 0; j < 4; ++j) pa[j] = pa[j] + pv[q][j]; } }
        if (nsplit > 0) {
#pragma unroll
            for (int j = 0; j < 4; ++j) { const int idx = 4 * (lane + 64 * j); v[j] = v[j] + (*(const f32x4*)(gatev + (size_t)bb * 6144 + idx) + 1.f) * pa[j];
                if (Xs) *(f32x4*)(Xs + (size_t)sr * DM + idx) = v[j]; } }
        float ss = 0.f;
#pragma unroll
        for (int j = 0; j < 4; ++j) ss += (v[j].x * v[j].x + v[j].y * v[j].y) + (v[j].z * v[j].z + v[j].w * v[j].w);
        const float rstd = rsqrtf(wave_sum(ss) * (1.f / DM) + EPSV);
        if (outb) {
            const float* sh = modl + (size_t)bb * 6144 + shift_i * 1024; const float* sc = modl + (size_t)bb * 6144 + scale_i * 1024;
#pragma unroll
            for (int j = 0; j < 4; ++j) { const int idx = 4 * (lane + 64 * j);
                const f32x4 y = v[j] * rstd * (*(const f32x4*)(g + idx)) * (*(const f32x4*)(sc + idx) + 1.f) + *(const f32x4*)(sh + idx);
                u32x2 w; w.x = pk2(y.x, y.y); w.y = pk2(y.z, y.w);
                *(u32x2*)(outb + (size_t)(TPROMPT + sr) * DM + idx) = w; }
        } else {
#pragma unroll
            for (int j = 0; j < 4; ++j) { const int idx = 4 * (lane + 64 * j); *(f32x4*)(Xs + (size_t)sr * DM + idx) = v[j] * rstd * (*(const f32x4*)(g + idx)); }
        }
    }
}
__device__ __forceinline__ void final_norm_phase(const float* X, const float* g, float* out, int lane, int wave) {
    const int gw = blockIdx.x * NWAVES + wave, NGW = gridDim.x * NWAVES;
    for (int row0 = gw * NRB; row0 < TPROMPT; row0 += NGW * NRB) {
        f32x4 v[NRB][4]; float ss[NRB];
#pragma unroll
        for (int r = 0; r < NRB; ++r) {
#pragma unroll
            for (int j = 0; j < 4; ++j) v[r][j] = *(const f32x4*)(X + (size_t)(row0 + r) * DM + 4 * (lane + 64 * j)); }
        f32x4 gs[4];
#pragma unroll
        for (int j = 0; j < 4; ++j) gs[j] = *(const f32x4*)(g + 4 * (lane + 64 * j));
#pragma unroll
        for (int r = 0; r < NRB; ++r) { float a = 0.f;
#pragma unroll
            for (int j = 0; j < 4; ++j) a += (v[r][j].x * v[r][j].x + v[r][j].y * v[r][j].y) + (v[r][j].z * v[r][j].z + v[r][j].w * v[r][j].w);
            ss[r] = a; }
#pragma unroll
        for (int o = 1; o < 64; o <<= 1) {
#pragma unroll
            for (int r = 0; r < NRB; ++r) ss[r] += __shfl_xor(ss[r], o); }
#pragma unroll
        for (int r = 0; r < NRB; ++r) { const int row = row0 + r; const float rstd = rsqrtf(ss[r] * (1.f / DM) + EPSV);
            float* orow = out + O_YP + (size_t)row * DM;
#pragma unroll
            for (int j = 0; j < 4; ++j) { const int idx = 4 * (lane + 64 * j); *(f32x4*)(orow + idx) = v[r][j] * rstd * gs[j]; } }
    }
}

__device__ __forceinline__ int crow(int r, int hi) { return (r & 3) + 8 * (r >> 2) + 4 * hi; }
__device__ __forceinline__ void sb_attn_phase(KA A, int lane, int wave) {
    const int gw = blockIdx.x * NWAVES + wave, NGW = gridDim.x * NWAVES;
    const int r32 = lane & 31, hi = lane >> 5;
    const bf16_t* QA = (const bf16_t*)(A->ws + WS_QA);
    const bf16_t* KBF = (const bf16_t*)(A->ws + WS_KBF);
    const bf16_t* VT = (const bf16_t*)(A->ws + WS_VT);
    bf16_t* OC = (bf16_t*)(A->ws + WS_ABUF);
    const int sblk0 = (gridDim.x >= 128) ? (int)gridDim.x / 4 : 0;
    const int nprompt_it = (4096 - gw + NGW - 1) / NGW;
    const int sfirst = ((int)blockIdx.x - sblk0) * NWAVES + wave, sstride = ((int)gridDim.x - sblk0) * NWAVES;
    const int nsample_it = (sfirst >= 0 && sfirst < 256) ? (256 - sfirst + sstride - 1) / sstride : 0;
    for (int ui = 0; ui < nprompt_it + nsample_it; ++ui) {
        const int wu = (ui < nprompt_it) ? gw + ui * NGW : 4096 + sfirst + (ui - nprompt_it) * sstride;
        int h, qb, P, qrow0, T; const float *Kpast, *Vpast; const bf16_t *Kn, *Vn;
        if (wu < 4096) { const int b = wu >> 11, rem = wu & 2047; h = rem >> 8; qb = rem & 255; P = 0; T = 8192; qrow0 = b * 8192 + 32 * qb;
            Kn = KBF + (size_t)b * 8192 * 512; Vn = VT + (size_t)(b * 8 + h) * 64 * 8192; Kpast = nullptr; Vpast = nullptr; }
        else { const int su = wu - 4096, bs = su >> 4; h = (su >> 1) & 7; qb = su & 1; P = PAST; T = 64; qrow0 = TPROMPT + bs * 64 + 32 * qb;
            Kn = KBF + (size_t)(TPROMPT + bs * 64) * 512; Vn = VT + (size_t)16 * 64 * 8192 + (size_t)(bs * 8 + h) * 64 * 64;
            Kpast = A->in[2] + (size_t)bs * PAST * 512; Vpast = A->in[3] + (size_t)bs * PAST * 512; }
        const int Q0 = P + 32 * qb, qpos = Q0 + r32;
        bf16x8 qr[4];
#pragma unroll
        for (int d0 = 0; d0 < 4; ++d0) qr[d0] = *(const bf16x8*)(QA + (size_t)(qrow0 + r32) * 512 + h * 64 + d0 * 16 + hi * 8);
        f32x16 o0, o1;
#pragma unroll
        for (int r = 0; r < 16; ++r) { o0[r] = 0.f; o1[r] = 0.f; }
        float carry = 0.f;
        for (int kt = Q0 >> 6; kt >= 0; --kt) {
            const int kb = kt * 64;
            bf16x8 kf[8], vf[8];
            if (kb >= P) {
                const bf16_t* kp = Kn + (size_t)(kb - P + r32) * 512 + h * 64 + hi * 8;
#pragma unroll
                for (int d0 = 0; d0 < 4; ++d0) { kf[2 * d0] = *(const bf16x8*)(kp + d0 * 16); kf[2 * d0 + 1] = *(const bf16x8*)(kp + 32 * 512 + d0 * 16); }
                const bf16_t* vp = Vn + (size_t)r32 * T + (kb - P) + 8 * hi;
#pragma unroll
                for (int jj = 0; jj < 4; ++jj) { vf[2 * jj] = *(const bf16x8*)(vp + 16 * jj); vf[2 * jj + 1] = *(const bf16x8*)(vp + (size_t)32 * T + 16 * jj); }
            } else {
                const float* Kt = Kpast + (size_t)kb * 512; const float* Vt = Vpast + (size_t)kb * 512;
#pragma unroll
                for (int d0 = 0; d0 < 4; ++d0) { const float* k0 = Kt + (size_t)r32 * 512 + h * 64 + d0 * 16 + hi * 8; const float* k1 = k0 + 32 * 512;
                    kf[2 * d0] = cvt8(*(const f32x4*)k0, *(const f32x4*)(k0 + 4)); kf[2 * d0 + 1] = cvt8(*(const f32x4*)k1, *(const f32x4*)(k1 + 4)); }
#pragma unroll
                for (int jj = 0; jj < 4; ++jj) { const float* vb = Vt + (size_t)(32 * (jj >> 1) + 16 * (jj & 1) + 4 * hi) * 512 + h * 64 + r32;
#pragma unroll
                    for (int dd = 0; dd < 2; ++dd) { const float* v = vb + 32 * dd;
                        u32x4 vw; vw.x = pk2(v[0], v[512]); vw.y = pk2(v[1024], v[1536]); vw.z = pk2(v[8 * 512], v[9 * 512]); vw.w = pk2(v[10 * 512], v[11 * 512]);
                        vf[2 * jj + dd] = __builtin_bit_cast(bf16x8, vw); } }
            }
            f32x16 p0, p1;
#pragma unroll
            for (int r = 0; r < 16; ++r) { p0[r] = 0.f; p1[r] = 0.f; }
#pragma unroll
            for (int d0 = 0; d0 < 4; ++d0) {
                p0 = __builtin_amdgcn_mfma_f32_32x32x16_bf16(kf[2 * d0], qr[d0], p0, 0, 0, 0);
                p1 = __builtin_amdgcn_mfma_f32_32x32x16_bf16(kf[2 * d0 + 1], qr[d0], p1, 0, 0, 0);
            }
            f32x16 s0, s1; float G[8];
#pragma unroll
            for (int g = 0; g < 4; ++g) {
                float run0 = 0.f, run1 = 0.f;
#pragma unroll
                for (int e = 3; e >= 0; --e) { const int r = 4 * g + e; const int key = kb + crow(r, hi);
                    const float z0 = p0[r], z1 = p1[r];
                    const float l0 = (key < qpos) ? -(fmaxf(z0, 0.f) + __logf(1.f + __expf(-fabsf(z0)))) : 0.f;
                    const float l1 = (key + 32 < qpos) ? -(fmaxf(z1, 0.f) + __logf(1.f + __expf(-fabsf(z1)))) : 0.f;
                    run0 += l0; run1 += l1; s0[r] = run0; s1[r] = run1; }
                G[g] = run0; G[4 + g] = run1;
            }
            float Gx[8], R[8];
#pragma unroll
            for (int g = 0; g < 8; ++g) Gx[g] = __shfl_xor(G[g], 32);
            float run = 0.f;
#pragma unroll
            for (int g = 7; g >= 0; --g) { R[g] = run; run += G[g] + Gx[g]; }
#pragma unroll
            for (int g = 0; g < 4; ++g) {
                const float off0 = carry + R[g] + (hi == 0 ? Gx[g] : 0.f), off1 = carry + R[4 + g] + (hi == 0 ? Gx[4 + g] : 0.f);
#pragma unroll
                for (int e = 0; e < 4; ++e) { const int r = 4 * g + e; const int key = kb + crow(r, hi);
                    p0[r] = (key < qpos) ? __expf(p0[r] + s0[r] + off0) : 0.f;
                    p1[r] = (key + 32 < qpos) ? __expf(p1[r] + s1[r] + off1) : 0.f; }
            }
            carry += run;
#pragma unroll
            for (int jj = 0; jj < 4; ++jj) {
                u32x4 pw;
                if (jj < 2) { const int b = 8 * jj; pw.x = pk2(p0[b], p0[b + 1]); pw.y = pk2(p0[b + 2], p0[b + 3]); pw.z = pk2(p0[b + 4], p0[b + 5]); pw.w = pk2(p0[b + 6], p0[b + 7]); }
                else { const int b = 8 * (jj - 2); pw.x = pk2(p1[b], p1[b + 1]); pw.y = pk2(p1[b + 2], p1[b + 3]); pw.z = pk2(p1[b + 4], p1[b + 5]); pw.w = pk2(p1[b + 6], p1[b + 7]); }
                const bf16x8 pa = __builtin_bit_cast(bf16x8, pw);
                o0 = __builtin_amdgcn_mfma_f32_32x32x16_bf16(pa, vf[2 * jj], o0, 0, 0, 0);
                o1 = __builtin_amdgcn_mfma_f32_32x32x16_bf16(pa, vf[2 * jj + 1], o1, 0, 0, 0);
            }
            if (__all(carry < -60.f)) break;
        }
        bf16_t* ob = OC + (size_t)qrow0 * DM + h * 64 + r32;
#pragma unroll
        for (int r = 0; r < 16; ++r) { const int q = crow(r, hi); ob[(size_t)q * DM] = (bf16_t)(pk2(o0[r], 0.f) & 0xffffu); ob[(size_t)q * DM + 32] = (bf16_t)(pk2(o1[r], 0.f) & 0xffffu); }
    }
}

__device__ __forceinline__ void hg_item(int it, int& tok0, int& h) { if (it < 1024) { const int b = it >> 9, n = (it >> 2) & 127; h = it & 3; tok0 = b * 8192 + n * 64; } else { const int s = it - 1024; h = s & 3; tok0 = TPROMPT + (s >> 2) * 64; } }
constexpr int HP = 72;
__device__ __forceinline__ unsigned off_b(unsigned row, unsigned ch) { return 256u * row + 16u * (ch ^ (((row & 3) << 2) | ((row >> 2) & 3))); }
__device__ __forceinline__ unsigned tr_addr16(unsigned lane, unsigned c, unsigned ks, unsigned t) { const unsigned g = lane >> 4, q = (lane & 15) >> 2, p = lane & 3; return off_b(32 * ks + 8 * g + 4 * t + q, 2 * c + (p >> 1)) + 8 * (p & 1); }
typedef unsigned short u16x4_t __attribute__((ext_vector_type(4)));
__device__ __forceinline__ bf16x8 tr_frag16(unsigned base, unsigned lane, unsigned c, unsigned ks) {
    u16x4_t r0, r1; const unsigned a0 = base + tr_addr16(lane, c, ks, 0), a1 = base + tr_addr16(lane, c, ks, 1);
    asm volatile("ds_read_b64_tr_b16 %0, %2\n\tds_read_b64_tr_b16 %1, %3\n\ts_waitcnt lgkmcnt(0)" : "=&v"(r0), "=&v"(r1) : "v"(a0), "v"(a1) : "memory");
    return (bf16x8){(short)r0[0], (short)r0[1], (short)r0[2], (short)r0[3], (short)r1[0], (short)r1[1], (short)r1[2], (short)r1[3]};
}
constexpr int RP = 136;
#define HG_PREFETCH(it_) do { int tokP, hP; hg_item((it_), tokP, hP); \
        _Pragma("unroll") for (int i = 0; i < 4; ++i) { const int idx = tid + 512 * i, t = idx >> 5, c4 = idx & 31; lfv[i] = *(const f32x4*)(LF + (size_t)(tokP + t) * 512 + hP * 128 + 4 * c4); } \
        _Pragma("unroll") for (int i = 0; i < 2; ++i) { const int idx = tid + 512 * i, t = idx >> 4, c8 = idx & 15; const size_t o = (size_t)(tokP + t) * 512 + hP * 128 + 8 * c8; \
            ibv[i] = *(const u32x4*)(IB + o); kbv[i] = *(const u32x4*)(KB + o); qbv[i] = *(const u32x4*)(QB + o); } } while (0)
__device__ __forceinline__ void hgrn_a_phase(KA A, LAS unsigned char* lds, int tid, int lane, int wave) {
    unsigned char* ws = A->ws;
    const bf16_t* QB = (const bf16_t*)(ws + WS_QB); const bf16_t* KB = (const bf16_t*)(ws + WS_KB); const bf16_t* IB = (const bf16_t*)(ws + WS_IB);
    const float* LF = (const float*)(ws + WS_LF);
    bf16_t* QT = (bf16_t*)(ws + WS_QT); float* OI = (float*)(ws + WS_OI); float* UT = (float*)(ws + WS_UT); float* DEC = (float*)(ws + WS_DEC);
    LAS float* Lb = (LAS float*)lds;
    LAS unsigned char* Vr = lds + 32768;
    LAS unsigned char* KUr = lds + 51200;
    LAS bf16_t* Pm = (LAS bf16_t*)(lds + 69632);
    LAS bf16_t* Qr = (LAS bf16_t*)(lds + 78848);
    LAS bf16_t* Kr = (LAS bf16_t*)(lds + 96256);
    LAS float* SEGB = (LAS float*)(lds + 113664);
    const int fr = lane & 15, fq = lane >> 4, cc = tid & 127, tq = wave >> 1;
    f32x4 lfv[4]; u32x4 ibv[2], kbv[2], qbv[2];
    int it = blockIdx.x;
    if (it < 1088) HG_PREFETCH(it);
    for (; it < 1088; it += gridDim.x) {
        int tok0, h; hg_item(it, tok0, h);
        f32x4 lfc[4]; u32x4 ibc[2], kbc[2], qbc[2];
#pragma unroll
        for (int i = 0; i < 4; ++i) lfc[i] = lfv[i];
#pragma unroll
        for (int i = 0; i < 2; ++i) { ibc[i] = ibv[i]; kbc[i] = kbv[i]; qbc[i] = qbv[i]; }
        asm volatile("" ::: "memory");
        if (it + (int)gridDim.x < 1088) HG_PREFETCH(it + (int)gridDim.x);
        asm volatile("" ::: "memory");
        LBAR();
#pragma unroll
        for (int i = 0; i < 4; ++i) { const int idx = tid + 512 * i, t = idx >> 5, c4 = idx & 31; *(LAS f32x4*)(Lb + t * 128 + 4 * c4) = lfc[i]; }
#pragma unroll
        for (int i = 0; i < 2; ++i) { const int idx = tid + 512 * i, t = idx >> 4, v8 = idx & 15;
            *(LAS u32x4*)(Vr + off_b(t, v8)) = ibc[i];
            *(LAS u32x4*)(Qr + t * RP + 8 * v8) = qbc[i]; *(LAS u32x4*)(Kr + t * RP + 8 * v8) = kbc[i]; }
        for (int i = tid; i < 64 * HP * 2 / 16; i += NTHREADS) *(LAS u32x4*)((LAS unsigned char*)Pm + 16 * i) = (u32x4){0u, 0u, 0u, 0u};
        LBAR();
        { float run = 0.f;
#pragma unroll
            for (int i = 0; i < 16; ++i) { const int t = 16 * tq + i; run += Lb[t * 128 + cc]; Lb[t * 128 + cc] = run; }
            SEGB[tq * 128 + cc] = run; }
        LBAR();
        if (tq > 0) { float off = 0.f;
#pragma unroll
            for (int sgm = 0; sgm < 3; ++sgm) if (sgm < tq) off += SEGB[sgm * 128 + cc];
#pragma unroll
            for (int i = 0; i < 16; ++i) { const int t = 16 * tq + i; Lb[t * 128 + cc] += off; } }
        LBAR();
#pragma unroll
        for (int i = 0; i < 2; ++i) { const int idx = tid + 512 * i, t = idx >> 4, c8 = idx & 15;
            const u32x4 kw = kbc[i], qw = qbc[i];
            float kf[8] = {bflo(kw.x), bfhi(kw.x), bflo(kw.y), bfhi(kw.y), bflo(kw.z), bfhi(kw.z), bflo(kw.w), bfhi(kw.w)};
            float qf[8] = {bflo(qw.x), bfhi(qw.x), bflo(qw.y), bfhi(qw.y), bflo(qw.z), bfhi(qw.z), bflo(qw.w), bfhi(qw.w)};
            float qo[8];
            float ku[8];
#pragma unroll
            for (int e = 0; e < 8; ++e) { const float bt = Lb[t * 128 + 8 * c8 + e], bl = Lb[63 * 128 + 8 * c8 + e];
                ku[e] = kf[e] * __expf(bl - bt); qo[e] = qf[e] * __expf(bt); }
            { u32x4 kv; kv.x = pk2(ku[0], ku[1]); kv.y = pk2(ku[2], ku[3]); kv.z = pk2(ku[4], ku[5]); kv.w = pk2(ku[6], ku[7]); *(LAS u32x4*)(KUr + off_b(t, c8)) = kv; }
            u32x4 qv; qv.x = pk2(qo[0], qo[1]); qv.y = pk2(qo[2], qo[3]); qv.z = pk2(qo[4], qo[5]); qv.w = pk2(qo[6], qo[7]);
            *(u32x4*)(QT + (size_t)(tok0 + t) * 512 + h * 128 + 8 * c8) = qv; }
        if (tid < 128) DEC[(size_t)it * 128 + tid] = __expf(Lb[63 * 128 + tid]);
        for (int bi = wave; bi < 10; bi += 8) {
            const int I = bi < 1 ? 0 : bi < 3 ? 1 : bi < 6 ? 2 : 3, J = bi - (I * (I + 1)) / 2;
            const int sI = 16 * J + fr, t = 16 * I + fr;
            f32x4 acc = {0.f, 0.f, 0.f, 0.f};
#pragma unroll
            for (int kk = 0; kk < 4; ++kk) {
                const int c0 = 32 * kk + 8 * fq;
                const u32x4 kw = *(const LAS u32x4*)(Kr + sI * RP + c0);
                const u32x4 qw = *(const LAS u32x4*)(Qr + t * RP + c0);
                float kf[8] = {bflo(kw.x), bfhi(kw.x), bflo(kw.y), bfhi(kw.y), bflo(kw.z), bfhi(kw.z), bflo(kw.w), bfhi(kw.w)};
                float qf[8] = {bflo(qw.x), bfhi(qw.x), bflo(qw.y), bfhi(qw.y), bflo(qw.z), bfhi(qw.z), bflo(qw.w), bfhi(qw.w)};
#pragma unroll
                for (int e = 0; e < 8; ++e) { const float BI = (I > 0) ? Lb[(16 * I - 1) * 128 + c0 + e] : 0.f;
                    kf[e] *= __expf(BI - Lb[sI * 128 + c0 + e]); qf[e] *= __expf(Lb[t * 128 + c0 + e] - BI); }
                u32x4 ka, qa; ka.x = pk2(kf[0], kf[1]); ka.y = pk2(kf[2], kf[3]); ka.z = pk2(kf[4], kf[5]); ka.w = pk2(kf[6], kf[7]);
                qa.x = pk2(qf[0], qf[1]); qa.y = pk2(qf[2], qf[3]); qa.z = pk2(qf[4], qf[5]); qa.w = pk2(qf[6], qf[7]);
                acc = __builtin_amdgcn_mfma_f32_16x16x32_bf16(__builtin_bit_cast(bf16x8, ka), __builtin_bit_cast(bf16x8, qa), acc, 0, 0, 0);
            }
            if (I == J) {
#pragma unroll
                for (int j = 0; j < 4; ++j) if (4 * fq + j > fr) acc[j] = 0.f; }
            u32x2 w; w.x = pk2(acc[0], acc[1]); w.y = pk2(acc[2], acc[3]);
            *(LAS u32x2*)(Pm + t * HP + 16 * J + 4 * fq) = w;
        }
        LBAR();
        {
            bf16x8 va[2];
#pragma unroll
            for (int ks = 0; ks < 2; ++ks) va[ks] = tr_frag16((unsigned)(size_t)Vr, (unsigned)lane, (unsigned)wave, (unsigned)ks);
#pragma unroll
            for (int ni = 0; ni < 4; ++ni) { f32x4 acc = {0.f, 0.f, 0.f, 0.f};
#pragma unroll
                for (int ks = 0; ks < 2; ++ks) { const bf16x8 pb = *(const LAS bf16x8*)(Pm + (16 * ni + fr) * HP + 32 * ks + 8 * fq); acc = __builtin_amdgcn_mfma_f32_16x16x32_bf16(va[ks], pb, acc, 0, 0, 0); }
                *(f32x4*)(OI + (size_t)(tok0 + 16 * ni + fr) * 512 + h * 128 + 16 * wave + 4 * fq) = acc; }
#pragma unroll
            for (int ni = 0; ni < 8; ++ni) { f32x4 acc = {0.f, 0.f, 0.f, 0.f};
#pragma unroll
                for (int ks = 0; ks < 2; ++ks) { const bf16x8 kb2 = tr_frag16((unsigned)(size_t)KUr, (unsigned)lane, (unsigned)ni, (unsigned)ks);
                    acc = (it < 1024) ? __builtin_amdgcn_mfma_f32_16x16x32_bf16(kb2, va[ks], acc, 0, 0, 0)
                                      : __builtin_amdgcn_mfma_f32_16x16x32_bf16(va[ks], kb2, acc, 0, 0, 0); }
                if (it < 1024) *(f32x4*)(UT + ((size_t)it * 128 + 16 * wave + fr) * 128 + 16 * ni + 4 * fq) = acc;
                else *(f32x4*)(UT + ((size_t)it * 128 + 16 * ni + fr) * 128 + 16 * wave + 4 * fq) = acc;
                }
        }
    }
    __syncthreads();
}
__device__ __forceinline__ void hgrn_b_phase(KA A, LAS unsigned char* lds, int tid) {
    unsigned char* ws = A->ws;
    const float* __restrict__ UT = (const float*)(ws + WS_UT); const float* __restrict__ DEC = (const float*)(ws + WS_DEC); bf16_t* __restrict__ SNT = (bf16_t*)(ws + WS_SNT);
    LAS float* T = (LAS float*)lds;
    for (int q = (int)blockIdx.x; q < 256; q += gridDim.x) {
        const int s0i = q >> 2, c0 = 32 * (q & 3);
        const size_t it = 1024 + s0i; const float* S0 = A->in[4] + (size_t)s0i * 16384 + c0 * 128; float* So = A->out + O_SS + (size_t)s0i * 16384 + c0 * 128;
        __syncthreads();
#pragma unroll
        for (int i = 0; i < 8; ++i) { const int e = tid + 512 * i, cl = e >> 7, v = e & 127; const float x = S0[e];
            T[cl * 129 + v] = x; So[e] = DEC[it * 128 + c0 + cl] * x + UT[it * 16384 + c0 * 128 + e]; }
        __syncthreads();
#pragma unroll
        for (int i = 0; i < 8; ++i) { const int e = tid + 512 * i, v = e >> 5, cl = e & 31; SNT[it * 16384 + v * 128 + c0 + cl] = (bf16_t)(pk2(T[cl * 129 + v], 0.f) & 0xffffu); }
    }
    const size_t gt = (size_t)blockIdx.x * NTHREADS + tid, GT = (size_t)gridDim.x * NTHREADS;
    for (size_t e = gt; e < 131072; e += GT) {
        const int bh = (int)(e >> 14), vc = (int)(e & 16383), v = vc >> 7, c = vc & 127, b = bh >> 2, h = bh & 3;
        float S = 0.f;
#pragma unroll 32
        for (int n = 0; n < 128; ++n) { const size_t it = (size_t)b * 512 + n * 4 + h;
            SNT[it * 16384 + vc] = (bf16_t)(pk2(S, 0.f) & 0xffffu);
            S = DEC[it * 128 + c] * S + UT[it * 16384 + vc]; }
        A->out[O_SP + ((size_t)(b * 4 + h) * 128 + c) * 128 + v] = S;
    }
}
__device__ __forceinline__ void hgrn_c_phase(KA A, int lane, int wave) {
    unsigned char* ws = A->ws;
    const bf16_t* SNT = (const bf16_t*)(ws + WS_SNT); const bf16_t* QT = (const bf16_t*)(ws + WS_QT); const float* OI = (const float*)(ws + WS_OI);
    const bf16_t* GB = (const bf16_t*)(ws + WS_GB); bf16_t* OC = (bf16_t*)(ws + WS_ABUF); const float* gn = A->in[15];
    const int gw = blockIdx.x * NWAVES + wave, NGW = gridDim.x * NWAVES, fr = lane & 15, fq = lane >> 4;
    for (int wi = gw; wi < 4352; wi += NGW) {
        const int it = wi >> 2, mt = wi & 3; int tok0, h; hg_item(it, tok0, h);
        const int tok = tok0 + 16 * mt + fr;
        f32x4 acc[8];
#pragma unroll
        for (int mi = 0; mi < 8; ++mi) acc[mi] = (f32x4){0.f, 0.f, 0.f, 0.f};
#pragma unroll
        for (int kk = 0; kk < 4; ++kk) {
            const bf16x8 qb = *(const bf16x8*)(QT + (size_t)tok * 512 + h * 128 + 32 * kk + 8 * fq);
#pragma unroll
            for (int mi = 0; mi < 8; ++mi) { const bf16x8 sa = *(const bf16x8*)(SNT + (size_t)it * 16384 + (32 * (mi >> 1) + 8 * (fr >> 2) + 4 * (mi & 1) + (fr & 3)) * 128 + 32 * kk + 8 * fq);
                acc[mi] = __builtin_amdgcn_mfma_f32_16x16x32_bf16(sa, qb, acc[mi], 0, 0, 0); }
        }
        float ss = 0.f;
#pragma unroll
        for (int mi = 0; mi < 8; ++mi) { acc[mi] = acc[mi] + *(const f32x4*)(OI + (size_t)tok * 512 + h * 128 + 32 * (mi >> 1) + 8 * fq + 4 * (mi & 1));
            ss += (acc[mi].x * acc[mi].x + acc[mi].y * acc[mi].y) + (acc[mi].z * acc[mi].z + acc[mi].w * acc[mi].w); }
        ss += __shfl_xor(ss, 16); ss += __shfl_xor(ss, 32);
        const float rstd = rsqrtf(ss * (1.f / 128.f) + EPSV);
#pragma unroll
        for (int mp = 0; mp < 4; ++mp) { const int vcol = h * 128 + 32 * mp + 8 * fq;
            const f32x4 g0 = *(const f32x4*)(gn + vcol), g1 = *(const f32x4*)(gn + vcol + 4); const u32x4 gw4 = *(const u32x4*)(GB + (size_t)tok * 512 + vcol);
            const f32x4 y0 = acc[2 * mp] * rstd * g0, y1 = acc[2 * mp + 1] * rstd * g1;
            u32x4 w; w.x = pk2(y0.x * bflo(gw4.x), y0.y * bfhi(gw4.x)); w.y = pk2(y0.z * bflo(gw4.y), y0.w * bfhi(gw4.y));
            w.z = pk2(y1.x * bflo(gw4.z), y1.y * bfhi(gw4.z)); w.w = pk2(y1.z * bflo(gw4.w), y1.w * bfhi(gw4.w));
            *(u32x4*)(OC + (size_t)tok * DM + 512 + vcol) = w; }
    }
}

constexpr int LP = 129;
__device__ __forceinline__ float neg_expm1(float x) {
    const float p = -x * (1.f + x * (0.5f + x * (0.16666667f + x * (0.041666668f + x * (0.008333334f + x * 0.0013888889f)))));
    return x > -0.25f ? p : 1.f - __expf(x);
}
#define LRU_DECODE(li_, tile_, blk_, prompt_, b_, n_, bs_, srow0_, tloc0_) \
    const int tile_ = (li_) >> 3, blk_ = (li_) & 7; const bool prompt_ = tile_ < 256; const int b_ = tile_ >> 7, n_ = tile_ & 127, bs_ = tile_ - 256; \
    const int srow0_ = prompt_ ? b_ * 8192 : TPROMPT + bs_ * 64; const int tloc0_ = prompt_ ? n_ * 64 : 0;
#define LRU_PREFETCH(li_) do { LRU_DECODE(li_, tileP, blkP, promptP, bP, nP, bsP, srow0P, tloc0P) \
        const int chP = blkP * 128 + c; const int p0P = tloc0P + 16 * tq; \
        const float* cpast = A->in[5]; \
        _Pragma("unroll") for (int hh = 0; hh < 3; ++hh) { const int pp = p0P - 3 + hh; \
            const float* src = (pp >= 0) ? XBR + (size_t)(srow0P + pp) * DM + chP : (promptP ? XBR + chP : cpast + (size_t)(bsP * 3 + 3 + pp) * 1024 + chP); \
            const float vv = *src; xh[hh] = (pp < 0 && promptP) ? 0.f : vv; } \
        _Pragma("unroll") for (int i = 0; i < 16; ++i) xn[i] = XBR[(size_t)(srow0P + p0P + i) * DM + chP]; } while (0)
template <bool UNUSED_>
__device__ __forceinline__ void lru_phase(KA A, LAS unsigned char* lds, int tid, int lane, int wave) {
    unsigned char* ws = A->ws;
    const float* XBR = (const float*)(ws + WS_XBR); const bf16_t* GG = (const bf16_t*)(ws + WS_GG); bf16_t* YIN = (bf16_t*)(ws + WS_ABUF);
    float* AGGA = (float*)(ws + WS_AGGA); float* AGGH = (float*)(ws + WS_AGGH); bf16_t* LAB = (bf16_t*)(ws + WS_LAB); bf16_t* UUB = (bf16_t*)(ws + WS_UUB);
    const bf16_t* WLA = (const bf16_t*)(ws + WS_WLRU); const bf16_t* WLX = WLA + 8 * 16384;
    LAS bf16_t* XCb = (LAS bf16_t*)lds;
    LAS float* XCf = (LAS float*)(lds + 17408);
    LAS float* Af = (LAS float*)(lds + 17408 + 33024);
    LAS float* Uf = (LAS float*)(lds + 17408 + 2 * 33024);
    LAS float* SEG = (LAS float*)(lds + 17408 + 3 * 33024);
    LAS float* SEG2 = SEG + 1024;
    const int fr = lane & 15, fq = lane >> 4, c = tid & 127, tq = wave >> 1;
    float xn[16], xh[3];
    int li = blockIdx.x;
    if (li < 2176) LRU_PREFETCH(li);
    for (; li < 2176; li += gridDim.x) {
        LRU_DECODE(li, tile, blk, prompt, b, n, bs, srow0, tloc0)
        const int ch0 = blk * 128, ch = ch0 + c, tok0 = srow0 + tloc0;
        const bool FIN = !prompt;
        const float cw0 = A->in[18][ch], cw1 = A->in[18][1024 + ch], cw2 = A->in[18][2048 + ch], cw3 = A->in[18][3072 + ch], cb = A->in[19][ch];
        bf16x8 wa[4], wx[4];
#pragma unroll
        for (int kk = 0; kk < 4; ++kk) { wa[kk] = *(const bf16x8*)(WLA + (size_t)blk * 16384 + (16 * wave + fr) * 128 + 32 * kk + 8 * fq);
                                         wx[kk] = *(const bf16x8*)(WLX + (size_t)blk * 16384 + (16 * wave + fr) * 128 + 32 * kk + 8 * fq); }
        float ba4[4], bx4[4], lam4[4];
#pragma unroll
        for (int j = 0; j < 4; ++j) { const int cj = ch0 + 16 * wave + 4 * fq + j; ba4[j] = A->in[21][cj]; bx4[j] = A->in[23][cj]; lam4[j] = A->in[24][cj]; }
        u32x4 gwv[2];
        if (FIN) {
#pragma unroll
            for (int i = 0; i < 2; ++i) { const int idx = tid + 512 * i, t = idx >> 4, c8 = idx & 15; gwv[i] = *(const u32x4*)(GG + (size_t)(tok0 + t) * DM + ch0 + 8 * c8); }
        }
        asm volatile("" ::: "memory");
        float xv[16], xm3 = xh[0], xm2 = xh[1], xm1 = xh[2];
#pragma unroll
        for (int i = 0; i < 16; ++i) xv[i] = xn[i];
        if (li + (int)gridDim.x < 2176) LRU_PREFETCH(li + (int)gridDim.x);
        asm volatile("" ::: "memory");
        LBAR();
#pragma unroll
        for (int i = 0; i < 16; ++i) { const int t = 16 * tq + i; const float x0 = xv[i];
            const float xc = cb + cw0 * xm3 + cw1 * xm2 + cw2 * xm1 + cw3 * x0;
            XCf[t * LP + c] = xc; XCb[t * 136 + c] = (bf16_t)(pk2(xc, 0.f) & 0xffffu);
            xm3 = xm2; xm2 = xm1; xm1 = x0; }
        LBAR();
        {
            f32x4 accA[4], accX[4];
#pragma unroll
            for (int ni = 0; ni < 4; ++ni) { accA[ni] = (f32x4){0.f, 0.f, 0.f, 0.f}; accX[ni] = (f32x4){0.f, 0.f, 0.f, 0.f}; }
#pragma unroll
            for (int kk = 0; kk < 4; ++kk) {
#pragma unroll
                for (int ni = 0; ni < 4; ++ni) { const bf16x8 xb = *(const LAS bf16x8*)(XCb + (16 * ni + fr) * 136 + 32 * kk + 8 * fq);
                    accA[ni] = __builtin_amdgcn_mfma_f32_16x16x32_bf16(wa[kk], xb, accA[ni], 0, 0, 0);
                    accX[ni] = __builtin_amdgcn_mfma_f32_16x16x32_bf16(wx[kk], xb, accX[ni], 0, 0, 0); }
            }
            float L8[4];
#pragma unroll
            for (int j = 0; j < 4; ++j) { const float e = __expf(-lam4[j]); L8[j] = -8.f * (e < 0.01f ? e * (1.f - e * (0.5f - e * 0.33333334f)) : __logf(1.f + e)); }
#pragma unroll
            for (int ni = 0; ni < 4; ++ni) { const int t = 16 * ni + fr;
#pragma unroll
                for (int j = 0; j < 4; ++j) { const int cl = 16 * wave + 4 * fq + j;
                    const float d1 = 1.f + __expf(fminf(-(accA[ni][j] + ba4[j]), 40.f)), d2 = 1.f + __expf(fminf(-(accX[ni][j] + bx4[j]), 40.f));
                    const float inv = __builtin_amdgcn_rcpf(d1 * d2); const float r = d2 * inv, gi = d1 * inv;
                    const float la = r * L8[j], a = __expf(la);
                    const float x2 = 2.f * la; const float px = -x2 * (1.f + x2 * (0.5f + x2 * (0.16666667f + x2 * (0.041666668f + x2 * (0.008333334f + x2 * 0.0013888889f)))));
                    float mult = __builtin_amdgcn_sqrtf(x2 > -0.25f ? px : 1.f - a * a);
                    if (prompt && n == 0 && t == 0) mult = 1.f;
                    const float xcv = XCf[t * LP + cl]; Af[t * LP + cl] = a; Uf[t * LP + cl] = mult * gi * xcv; if (!FIN) XCf[t * LP + cl] = la; }
            }
        }
        LBAR();
        {
            float Ac = 1.f, hl = 0.f;
#pragma unroll
            for (int i = 0; i < 16; ++i) { const int t = 16 * tq + i; const float a = Af[t * LP + c]; hl = a * hl + Uf[t * LP + c]; Ac *= a; }
            SEG[(tq * 128 + c) * 2] = Ac; SEG[(tq * 128 + c) * 2 + 1] = hl;
        }
        LBAR();
        if (!FIN) {
#pragma unroll
            for (int i = 0; i < 2; ++i) { const int idx = tid + 512 * i, t = idx >> 4, c8 = idx & 15;
                const LAS float* lp = XCf + t * LP + 8 * c8; const LAS float* up = Uf + t * LP + 8 * c8;
                u32x4 w1, w2; w1.x = pk2(lp[0], lp[1]); w1.y = pk2(lp[2], lp[3]); w1.z = pk2(lp[4], lp[5]); w1.w = pk2(lp[6], lp[7]);
                w2.x = pk2(up[0], up[1]); w2.y = pk2(up[2], up[3]); w2.z = pk2(up[4], up[5]); w2.w = pk2(up[6], up[7]);
                *(u32x4*)(LAB + (size_t)(tok0 + t) * DM + ch0 + 8 * c8) = w1; *(u32x4*)(UUB + (size_t)(tok0 + t) * DM + ch0 + 8 * c8) = w2; }
            { const bool last_tile = prompt ? (n == 127) : true;
              if (last_tile && tid < 384) { const int j = tid >> 7; const int T = prompt ? 8192 : 64;
                const float xo = XBR[(size_t)(srow0 + T - 3 + j) * DM + ch];
                if (prompt) A->out[O_CP + (size_t)(b * 3 + j) * 1024 + ch] = xo; else A->out[O_CS + (size_t)(bs * 3 + j) * 1024 + ch] = xo; } }
            if (tq == 0) { float Aa = 1.f, H = 0.f;
#pragma unroll
                for (int s = 0; s < 4; ++s) { const float as = SEG[(s * 128 + c) * 2], hs = SEG[(s * 128 + c) * 2 + 1]; H = as * H + hs; Aa *= as; }
                AGGA[(size_t)tile * 1024 + ch] = Aa; AGGH[(size_t)tile * 1024 + ch] = H; }
        } else {
            float hin;
            hin = A->in[6][(size_t)bs * 1024 + ch];
            float hcur = hin;
#pragma unroll
            for (int s = 0; s < 3; ++s) if (s < tq) hcur = SEG[(s * 128 + c) * 2] * hcur + SEG[(s * 128 + c) * 2 + 1];
#pragma unroll
            for (int i = 0; i < 16; ++i) { const int t = 16 * tq + i; hcur = Af[t * LP + c] * hcur + Uf[t * LP + c]; Uf[t * LP + c] = hcur; }
            const bool last_tile = prompt ? (n == 127) : true;
            if (last_tile && tq == 3) { if (prompt) A->out[O_HP + (size_t)b * 1024 + ch] = hcur; else A->out[O_HS + (size_t)bs * 1024 + ch] = hcur; }
            if (last_tile && tid < 384) { const int j = tid >> 7; const int T = prompt ? 8192 : 64;
                const float xo = XBR[(size_t)(srow0 + T - 3 + j) * DM + ch];
                if (prompt) A->out[O_CP + (size_t)(b * 3 + j) * 1024 + ch] = xo; else A->out[O_CS + (size_t)(bs * 3 + j) * 1024 + ch] = xo; }
            LBAR();
#pragma unroll
            for (int i = 0; i < 2; ++i) { const int idx = tid + 512 * i, t = idx >> 4, c8 = idx & 15;
                const u32x4 gw4 = gwv[i];
                const LAS float* hp = Uf + t * LP + 8 * c8;
                u32x4 w; w.x = pk2(bflo(gw4.x) * hp[0], bfhi(gw4.x) * hp[1]); w.y = pk2(bflo(gw4.y) * hp[2], bfhi(gw4.y) * hp[3]);
                w.z = pk2(bflo(gw4.z) * hp[4], bfhi(gw4.z) * hp[5]); w.w = pk2(bflo(gw4.w) * hp[6], bfhi(gw4.w) * hp[7]);
                *(u32x4*)(YIN + (size_t)(tok0 + t) * DM + ch0 + 8 * c8) = w; }
        }
    }
    __syncthreads();
}

__device__ __forceinline__ void lru_final_phase(KA A, int lane, int wave) {
    unsigned char* ws = A->ws;
    const bf16_t* __restrict__ GG = (const bf16_t*)(ws + WS_GG); bf16_t* __restrict__ YIN = (bf16_t*)(ws + WS_ABUF);
    const float* __restrict__ AGGA = (const float*)(ws + WS_AGGA); const float* __restrict__ AGGH = (const float*)(ws + WS_AGGH);
    const bf16_t* __restrict__ LAB = (const bf16_t*)(ws + WS_LAB); const bf16_t* __restrict__ UUB = (const bf16_t*)(ws + WS_UUB);
    const int gw = blockIdx.x * NWAVES + wave, NGW = gridDim.x * NWAVES;
    for (int wi = gw; wi < 256 * 16; wi += NGW) {
        const int tile = wi >> 4, ch = (wi & 15) * 64 + lane;
        const bool prompt = tile < 256; const int b = tile >> 7, n = tile & 127, bs = tile - 256;
        const int tok0 = prompt ? b * 8192 + n * 64 : TPROMPT + bs * 64;
        float h;
        if (prompt) { h = 0.f; const float* pa = AGGA + (size_t)(b * 128) * 1024 + ch; const float* ph = AGGH + (size_t)(b * 128) * 1024 + ch;
#pragma unroll 16
            for (int np = 0; np < n; ++np) h = pa[(size_t)np * 1024] * h + ph[(size_t)np * 1024]; }
        else h = A->in[6][(size_t)bs * 1024 + ch];
        const size_t o0 = (size_t)tok0 * DM + ch;
#pragma unroll
        for (int g = 0; g < 4; ++g) {
            bf16_t lav[16], uv[16], gv[16];
#pragma unroll
            for (int i = 0; i < 16; ++i) { const size_t o = o0 + (size_t)(16 * g + i) * DM; lav[i] = LAB[o]; uv[i] = UUB[o]; gv[i] = GG[o]; }
#pragma unroll
            for (int i = 0; i < 16; ++i) { const float a = __expf(__uint_as_float((unsigned)lav[i] << 16)); h = a * h + __uint_as_float((unsigned)uv[i] << 16);
                YIN[o0 + (size_t)(16 * g + i) * DM] = (bf16_t)(pk2(__uint_as_float((unsigned)gv[i] << 16) * h, 0.f) & 0xffffu); }
        }
        const bool last_tile = prompt ? (n == 127) : true;
        if (last_tile) { if (prompt) A->out[O_HP + (size_t)b * 1024 + ch] = h; else A->out[O_HS + (size_t)bs * 1024 + ch] = h; }
    }
}

#define XB_XCNT(j)  (256  + 64 * (j))
#define XB_XSUB(j)  (1280 + 64 * (j))
#define XB_XGEN(j)  (2304 + 64 * (j))
#define XB_TOP      3328
#define XB_TOPGEN   3392
#define XCD_BAR_WORDS 3456
__device__ __forceinline__ unsigned xb_ld(unsigned* p)              { return __hip_atomic_load(p, __ATOMIC_RELAXED, __HIP_MEMORY_SCOPE_AGENT); }
__device__ __forceinline__ unsigned xb_add(unsigned* p, unsigned v) { return __hip_atomic_fetch_add(p, v, __ATOMIC_RELAXED, __HIP_MEMORY_SCOPE_AGENT); }
__device__ __forceinline__ unsigned xb_xcc_id() { return (unsigned)__builtin_amdgcn_s_getreg((3 << 11) | 20) & 0xFu; }
__device__ __forceinline__ void xb_census(unsigned* bar, unsigned xcc, volatile LAS unsigned* st) {
    const unsigned G = gridDim.x;
    for (;;) {
        unsigned sum = 0u, cnt = 0u, mine = 0u;
        for (unsigned j = 0; j < 16; ++j) { const unsigned c = xb_ld(&bar[XB_XCNT(j)]); sum += c; cnt += (c > 0u) ? 1u : 0u; mine = (j == xcc) ? c : mine; }
        if (sum == G) { st[0] = mine; st[1] = cnt; break; }
        __builtin_amdgcn_s_sleep(1);
    }
}
template <bool FIRST>
__device__ __forceinline__ void xbar(unsigned* bar, const unsigned xcc, volatile LAS unsigned* st) {
    asm volatile("s_waitcnt vmcnt(0)" ::: "memory");
    __syncthreads();
    if (__builtin_amdgcn_readfirstlane(threadIdx.x >> 6) == 0) {
        const bool l0 = (threadIdx.x == 0);
        __builtin_amdgcn_s_waitcnt(0);
        if (FIRST) { if (l0) xb_census(bar, xcc, st); }
        const unsigned nloc = __builtin_amdgcn_readfirstlane(st[0]), nx = __builtin_amdgcn_readfirstlane(st[1]);
        unsigned old = 0u; if (l0) old = xb_add(&bar[XB_XSUB(xcc)], 1u);
        old = __builtin_amdgcn_readfirstlane(old);
        const unsigned gen = old / nloc;
        if (old + 1u == (gen + 1u) * nloc) {
            __builtin_amdgcn_fence(__ATOMIC_RELEASE, "agent");
            asm volatile("s_waitcnt vmcnt(0)" ::: "memory");
            unsigned og = 0u; if (l0) og = xb_add(&bar[XB_TOP], 1u);
            og = __builtin_amdgcn_readfirstlane(og);
            const unsigned tg = og / nx;
            if (og + 1u == (tg + 1u) * nx) { if (l0) xb_add(&bar[XB_TOPGEN], 1u); }
            else { while (__builtin_amdgcn_readfirstlane(xb_ld(&bar[XB_TOPGEN])) == tg) __builtin_amdgcn_s_sleep(1); }
            __builtin_amdgcn_fence(__ATOMIC_ACQUIRE, "agent");
            if (l0) xb_add(&bar[XB_XGEN(xcc)], 1u);
            asm volatile("s_waitcnt vmcnt(0)" ::: "memory");
        } else {
            while (__builtin_amdgcn_readfirstlane(xb_ld(&bar[XB_XGEN(xcc)])) == gen) __builtin_amdgcn_s_sleep(1);
            __builtin_amdgcn_fence(__ATOMIC_ACQUIRE, "agent");
            asm volatile("s_waitcnt vmcnt(0)" ::: "memory");
        }
    }
    __syncthreads();
}

constexpr int NPHASE = 19;
#define REP_P0 1
#define REP_HA 1
#define REP_SB 1
#define REP_HB 1
#define REP_HC 1
#define REP_L1 1
#define REP_L2 1

#ifndef EN_P0
#define EN_P0 1
#endif
#ifndef EN_HA
#define EN_HA 1
#endif
#ifndef EN_SB
#define EN_SB 1
#endif
#ifndef EN_LRU
#define EN_LRU 1
#endif
#ifndef EN_HC
#define EN_HC 1
#endif

__global__ void __launch_bounds__(NTHREADS, 2) mega_fwd(Args Araw) {
    KA A = kargs();
    extern __shared__ __attribute__((aligned(16))) unsigned char lds_raw[];
    LAS unsigned char* lds = (LAS unsigned char*)lds_raw;
    const int tid = threadIdx.x, lane = tid & 63, wave = __builtin_amdgcn_readfirstlane(tid >> 6);
    unsigned char* ws = A->ws;
    const float* MOD = (const float*)(ws + WS_MOD);
    bf16_t* XB = (bf16_t*)(ws + WS_X);
    float* XSF = (float*)(ws + WS_X + 40 * MiB);
    bf16_t* ABUF = (bf16_t*)(ws + WS_ABUF);
    bf16_t* ABUF2 = (bf16_t*)(ws + WS_ABUF2);
    bf16_t* ACT = (bf16_t*)(ws + WS_ACT);
    const int lo = A->ph_lo, hi = A->ph_hi;
    unsigned* bar = (unsigned*)ws;
    volatile LAS unsigned* st = (volatile LAS unsigned*)(lds + RING_BYTES + 64);
    if (tid < 2) st[tid] = 0u;
    __syncthreads();
    if (hi > 1000) cg::this_grid().sync();
    const unsigned xcc = xb_xcc_id();
    if (tid == 0) (void)xb_add(&bar[XB_XCNT(xcc)], 1u);
#define IN(k) (lo <= (k) && (k) < hi)
#define SEAM(k) do { if (IN(k) && IN((k) + 1)) { if ((k) == 0) xbar<true>(bar, xcc, st); else xbar<false>(bar, xcc, st); } } while (0)
#define MODL(layer) (MOD + (size_t)(layer) * NBB * 6144)
#define GEMM_RES(PH, APTR, WPTR, KK, XOP, XOBF, XWP, LAYER, GI, NG, NSC, NSH, HNP, OUTP, FI) if (IN(PH)) { \
        { pg8::Gemm g{APTR, WPTR, TPROMPT, 1024, KK, KK}; pg8::StaticOrder S; S.init(TPROMPT, 1024, gridDim.x, blockIdx.x); \
          EpiResNorm<(FI) == 3, XOBF> E{XOP, XWP, MODL(LAYER) + (GI) * 1024, NG, NSC, NSH, HNP, OUTP, (float*)(ws + WS_SLOTS), (unsigned*)(ws + WS_CNT) + (FI) * 4096}; \
          pg8::gemm_phase<EpiResNorm<(FI) == 3, XOBF>, pg8::StaticOrder, false, true>(lds, g, S, E); } \
        { pg8::Gemm g{APTR, WPTR, MROWS, 1024, 256, KK}; SplitOrder<(KK) / 256> S{(int)gridDim.x, (int)blockIdx.x}; \
          EpiPart E{(float*)(ws + WS_PART)}; \
          pg8::gemm_phase<EpiPart, SplitOrder<(KK) / 256>, false, true>(lds, g, S, E); } } SEAM(PH);
#define GEMM_GU(PH, LAYER) if (IN(PH)) { \
        pg8::Gemm g{ABUF2, (const bf16_t*)(ws + WS_WGU) + (size_t)(LAYER) * 5632 * 1024, MROWS, 5632, 1024, 1024}; pg8::StaticOrder S; S.init(MROWS, 5632, gridDim.x, blockIdx.x); \
        EpiGU E{ACT}; pg8::gemm_phase<EpiGU, pg8::StaticOrder, true, true>(lds, g, S, E); } SEAM(PH);
    if (IN(0)) { for (int rp = 0; rp < REP_P0; ++rp) prologue_phase(kargs(), lds, tid, lane, wave); } SEAM(0);
    if (IN(1)) norm_mod_phase(A->in[0], A->in[1], A->in[9], MODL(0), 0, 1, ABUF, lane, wave, nullptr, 0, nullptr, nullptr, true, blockIdx.x * NWAVES + wave, gridDim.x * NWAVES); SEAM(1);
    if (IN(2)) {
        pg8::Gemm g{ABUF, (const bf16_t*)(ws + WS_WINE), MROWS, 3584, 1024, 1024}; pg8::StaticOrder S; S.init(MROWS, 3584, gridDim.x, blockIdx.x);
        EpiInEven E{A->out, (bf16_t*)(ws + WS_QA), (bf16_t*)(ws + WS_QB), (bf16_t*)(ws + WS_KB), (bf16_t*)(ws + WS_IB), (bf16_t*)(ws + WS_GB), (float*)(ws + WS_LF), (const float*)(ws + WS_LB), (bf16_t*)(ws + WS_KBF), (bf16_t*)(ws + WS_VT)};
        pg8::gemm_phase<EpiInEven, pg8::StaticOrder, true, true>(lds, g, S, E);
        convert_in_slack<1>(kargs(), lds, lane, wave, (MROWS / 256) * (3584 / 256));
    } SEAM(2);
    if (IN(3)) { for (int rp = 0; rp < REP_HA; ++rp) hgrn_a_phase(kargs(), lds, tid, lane, wave); for (int rp = 0; rp < REP_SB; ++rp) sb_attn_phase(kargs(), lane, wave); } SEAM(3);
    if (IN(4)) { for (int rp = 0; rp < REP_HB; ++rp) hgrn_b_phase(kargs(), lds, tid); } SEAM(4);
    if (IN(5)) { for (int rp = 0; rp < REP_HC; ++rp) hgrn_c_phase(kargs(), lane, wave); } SEAM(5);
    GEMM_RES(6, ABUF, (const bf16_t*)(ws + WS_WOUTE), 1024, A->in[0], false, XB, 0, 2, A->in[10], MODL(0) + 4 * 1024, MODL(0) + 3 * 1024, ABUF2, nullptr, 0)
    if (IN(7)) norm_mod_phase(nullptr, A->in[1], A->in[10], MODL(0), 3, 4, ABUF2, lane, wave, (const float*)(ws + WS_PART), 4, MODL(0) + 2 * 1024, XSF, false, (wave < 4) ? (int)blockIdx.x * 4 + wave : TSAMPLE, (int)gridDim.x * 4); SEAM(7);
    if (IN(8)) { pg8::Gemm g{ABUF2, (const bf16_t*)(ws + WS_WGU), MROWS, 5632, 1024, 1024}; pg8::StaticOrder S; S.init(MROWS, 5632, gridDim.x, blockIdx.x);
        EpiGU E{ACT}; pg8::gemm_phase<EpiGU, pg8::StaticOrder, true, true>(lds, g, S, E);
        convert_in_slack<2>(kargs(), lds, lane, wave, (MROWS / 256) * (5632 / 256)); } SEAM(8);
    GEMM_RES(9, ACT, (const bf16_t*)(ws + WS_WD), DFF, XB, true, XB, 0, 5, A->in[9] + 1024, MODL(1) + 1 * 1024, MODL(1) + 0 * 1024, ABUF2, nullptr, 1)
    if (IN(10)) norm_mod_phase(nullptr, XSF, A->in[9] + 1024, MODL(1), 0, 1, ABUF2, lane, wave, (const float*)(ws + WS_PART), 11, MODL(0) + 5 * 1024, XSF, false, (wave < 4) ? (int)blockIdx.x * 4 + wave : TSAMPLE, (int)gridDim.x * 4); SEAM(10);
    if (IN(11)) {
        pg8::Gemm g{ABUF2, (const bf16_t*)(ws + WS_WINO), MROWS, 2048, 1024, 1024}; pg8::StaticOrder S; S.init(MROWS, 2048, gridDim.x, blockIdx.x);
        EpiInOdd E{(bf16_t*)(ws + WS_GG), (float*)(ws + WS_XBR)};
        pg8::gemm_phase<EpiInOdd, pg8::StaticOrder, true, true>(lds, g, S, E);
        convert_in_slack<3>(kargs(), lds, lane, wave, (MROWS / 256) * (2048 / 256));
    } SEAM(11);
    if (IN(12)) { for (int rp = 0; rp < REP_L1; ++rp) lru_phase<false>(kargs(), lds, tid, lane, wave); } SEAM(12);
    if (IN(13)) { for (int rp = 0; rp < REP_L2; ++rp) lru_final_phase(kargs(), lane, wave); } SEAM(13);
    GEMM_RES(14, ABUF, (const bf16_t*)(ws + WS_WOUTO), 1024, XB, true, XB, 1, 2, A->in[10] + 1024, MODL(1) + 4 * 1024, MODL(1) + 3 * 1024, ABUF2, nullptr, 2)
    if (IN(15)) norm_mod_phase(nullptr, XSF, A->in[10] + 1024, MODL(1), 3, 4, ABUF2, lane, wave, (const float*)(ws + WS_PART), 4, MODL(1) + 2 * 1024, XSF, false, (wave < 4) ? (int)blockIdx.x * 4 + wave : TSAMPLE, (int)gridDim.x * 4); SEAM(15);
    GEMM_GU(16, 1)
    GEMM_RES(17, ACT, (const bf16_t*)(ws + WS_WD) + (size_t)1024 * DFF, DFF, XB, true, nullptr, 1, 5, A->in[29], nullptr, nullptr, nullptr, A->out + O_YP, 3)
    if (IN(18)) norm_mod_phase(nullptr, XSF, A->in[29], MODL(1), 0, 0, nullptr, lane, wave, (const float*)(ws + WS_PART), 11, MODL(1) + 5 * 1024, A->out + O_YS, false, (wave < 4) ? (int)blockIdx.x * 4 + wave : TSAMPLE, (int)gridDim.x * 4);
#undef IN
#undef SEAM
}

#ifndef MK_PER_PHASE
#define MK_PER_PHASE 0
#endif
extern "C" void kernel_launch(void* const* d_in, const int* in_sizes, int n_in, void* d_out, int out_size, void* d_ws, size_t ws_size, hipStream_t stream) {
    static int grid = 0;
    if (grid == 0) {
        if (n_in != 30 || out_size != (int)O_END || ws_size < WS_END) { fprintf(stderr, "kernel_launch: unexpected shapes n_in %d out %d ws %zu\n", n_in, out_size, ws_size); grid = -1; return; }
        int dev = 0, cus = 0, per_cu = 0;
        if (hipGetDevice(&dev) != hipSuccess || hipDeviceGetAttribute(&cus, hipDeviceAttributeMultiprocessorCount, dev) != hipSuccess) { grid = -1; return; }
        if (hipFuncSetAttribute((const void*)mega_fwd, hipFuncAttributeMaxDynamicSharedMemorySize, LDS_BYTES) != hipSuccess) { fprintf(stderr, "kernel_launch: hipFuncSetAttribute failed\n"); grid = -1; return; }
        if (hipOccupancyMaxActiveBlocksPerMultiprocessor(&per_cu, (const void*)mega_fwd, NTHREADS, LDS_BYTES) != hipSuccess || per_cu < 1) { fprintf(stderr, "kernel_launch: occupancy query says %d\n", per_cu); per_cu = 1; }
        (void)hipGetLastError();
        grid = cus >= 256 ? 256 : cus;
        if (grid != 256) fprintf(stderr, "kernel_launch: %d CUs: this build expects 256 workgroups (MI355X)\n", cus);
    }
    if (grid < 0) return;
    Args a{};
    for (int i = 0; i < 30; ++i) a.in[i] = (const float*)d_in[i];
    a.out = (float*)d_out; a.ws = (unsigned char*)d_ws;
#if MK_PER_PHASE
    for (int p = 0; p < NPHASE; ++p) { a.ph_lo = p; a.ph_hi = p + 1; hipLaunchKernelGGL(mega_fwd, dim3(grid), dim3(NTHREADS), LDS_BYTES, stream, a); }
#else
    a.ph_lo = 0; a.ph_hi = NPHASE;
    if (hipMemsetAsync(d_ws, 0, 131072, stream) != hipSuccess) { fprintf(stderr, "kernel_launch: memset of the barrier words failed\n"); return; }
    void* args[] = {&a};
    hipError_t e = hipLaunchCooperativeKernel((const void*)mega_fwd, dim3(grid), dim3(NTHREADS), args, LDS_BYTES, stream);
    if (e != hipSuccess) fprintf(stderr, "cooperative launch failed: %s (grid %d)\n", hipGetErrorString(e), grid);
#endif
}
```
